# Optimizing an MI355X kernel written in HIP

```python
import math
import jax
import jax.numpy as jnp
from jax import lax
import numpy as np

D_MODEL = 1024
BATCH = 8
SEQ = 2048
DEPTH = 4

HEAD_DIM = 64
A_HEADS = 8
A_WIDTH = A_HEADS * HEAD_DIM
DILATED_PATTERNS = ((128, 1), (512, 4), (2048, 16))
DIL_BLOCK = 128
DIFF_HEADS = 4
DIFF_QK_WIDTH = 2 * DIFF_HEADS * HEAD_DIM
DIFF_V_DIM = 2 * HEAD_DIM
DIFF_V_WIDTH = DIFF_HEADS * DIFF_V_DIM
Q_BLOCK = 128
ATT_IN_WIDTH = 3 * A_WIDTH + 2 * DIFF_QK_WIDTH + DIFF_V_WIDTH
ATT_MIX_WIDTH = A_WIDTH + DIFF_V_WIDTH
ROPE_THETA = 10000.0
HGRN_EXPAND = 128
HGRN_HEADS = D_MODEL // HGRN_EXPAND
HGRN_KEY_DIM = HGRN_EXPAND
HGRN_VAL_DIM = D_MODEL // HGRN_HEADS
HGRN_FORGET_WIDTH = HGRN_HEADS * HGRN_KEY_DIM
HGRN_VAL_WIDTH = HGRN_HEADS * HGRN_VAL_DIM
REC_IN_WIDTH = 2 * HGRN_FORGET_WIDTH + 2 * HGRN_VAL_WIDTH
REC_MIX_WIDTH = HGRN_VAL_WIDTH
HGRN_CHUNK = 64
FFN_HIDDEN = (8 * D_MODEL + 3 * 256 - 1) // (3 * 256) * 256
N_ATT_LAYERS = (DEPTH + 1) // 2
N_REC_LAYERS = DEPTH // 2
NORM_EPS = 1e-6
NEG_INF = -1e30

kernel_name = 'hybrid_dilated_diff_hgrn2_trunk'


def rms_norm(x, gain):
    xf = x.astype(jnp.float32)
    y = xf * lax.rsqrt(jnp.mean(xf * xf, axis=-1, keepdims=True) + NORM_EPS)
    return (y * gain.astype(jnp.float32)).astype(x.dtype)


def rope_tables(seq_len, dim):
    inv_freq = ROPE_THETA ** (-jnp.arange(0, dim, 2, dtype=jnp.float32) / dim)
    ang = jnp.arange(seq_len, dtype=jnp.float32)[:, None] * inv_freq[None, :]
    return jnp.cos(ang), jnp.sin(ang)


def apply_rope(x, cos, sin):
    xf = x.astype(jnp.float32)
    x1, x2 = jnp.split(xf, 2, axis=-1)
    out = jnp.concatenate([x1 * cos - x2 * sin, x2 * cos + x1 * sin], axis=-1)
    return out.astype(x.dtype)


def split_heads(t, n_heads, head_dim):
    b, s, _ = t.shape
    return t.reshape(b, s, n_heads, head_dim).transpose(0, 2, 1, 3)


def merge_heads(t):
    b, h, s, d = t.shape
    return t.transpose(0, 2, 1, 3).reshape(b, s, h * d)


def dilated_window_attention(q, k, v, window, dilation):
    b, h, s, d = q.shape
    span = window // dilation
    L = s // dilation
    nb = -(-L // DIL_BLOCK)
    Lp = nb * DIL_BLOCK

    def to_blocks(t):
        t = t.reshape(b, h, L, dilation, d).transpose(0, 1, 3, 2, 4)
        t = jnp.pad(t, ((0, 0), (0, 0), (0, 0), (0, Lp - L), (0, 0)))
        return t.reshape(b, h, dilation, nb, DIL_BLOCK, d)

    qb, kb, vb = to_blocks(q), to_blocks(k), to_blocks(v)

    def with_prev(t):
        prev = jnp.pad(t, ((0, 0), (0, 0), (0, 0), (1, 0), (0, 0), (0, 0)))[:, :, :, :-1]
        return jnp.concatenate([prev, t], axis=4)

    kc, vc = with_prev(kb), with_prev(vb)
    scores = jnp.einsum('bhrnqd,bhrnkd->bhrnqk', qb, kc).astype(jnp.float32) * (d ** -0.5)
    qi = jnp.arange(DIL_BLOCK)[:, None]
    ki = jnp.arange(2 * DIL_BLOCK)[None, :] - DIL_BLOCK
    rel = qi - ki
    key_idx = jnp.arange(nb)[:, None, None] * DIL_BLOCK + ki[None]
    mask = (rel >= 0) & (rel <= span) & (key_idx >= 0)
    scores = jnp.where(mask, scores, NEG_INF)
    lse = jax.nn.logsumexp(scores, axis=-1)
    probs = jnp.exp(scores - lse[..., None])
    out = jnp.einsum('bhrnqk,bhrnkd->bhrnqd', probs, vc.astype(jnp.float32))

    def from_blocks(t):
        t = t.reshape(b, h, dilation, Lp, t.shape[-1])[:, :, :, :L]
        return t.transpose(0, 1, 3, 2, 4).reshape(b, h, s, t.shape[-1])

    return from_blocks(out), from_blocks(lse[..., None])[..., 0]


def longnet_attention(q, k, v):
    outs, lses = [], []
    for window, dilation in DILATED_PATTERNS:
        o, l = dilated_window_attention(q, k, v, window, dilation)
        outs.append(o)
        lses.append(l)
    weights = jax.nn.softmax(jnp.stack(lses), axis=0)
    return jnp.einsum('pbhs,pbhsd->bhsd', weights, jnp.stack(outs)).astype(q.dtype)


def differential_attention(q, k, v, lam):
    b, h2, s, d = q.shape
    h = h2 // 2
    nb = s // Q_BLOCK
    q_blocks = q.reshape(b, h2, nb, Q_BLOCK, d).transpose(2, 0, 1, 3, 4)
    key_pos = jnp.arange(s)
    vf = v.astype(jnp.float32)

    def one_block(args):
        q_blk, blk_idx = args
        sc = jnp.einsum('bhqd,bhkd->bhqk', q_blk, k).astype(jnp.float32) * (d ** -0.5)
        q_pos = blk_idx * Q_BLOCK + jnp.arange(Q_BLOCK)
        sc = jnp.where(key_pos[None, :] <= q_pos[:, None], sc, NEG_INF)
        p = jax.nn.softmax(sc, axis=-1).reshape(b, h, 2, Q_BLOCK, s)
        w = p[:, :, 0] - lam * p[:, :, 1]
        return jnp.einsum('bhqk,bhkd->bhqd', w, vf)

    out = lax.map(one_block, (q_blocks, jnp.arange(nb)))
    return out.transpose(1, 2, 0, 3, 4).reshape(b, h, s, v.shape[-1])


def attention_mixer(h, w_in, lambda_params, subln_gain, w_out, lambda_init, cos, sin):
    proj = h @ w_in
    cuts = [A_WIDTH, 2 * A_WIDTH, 3 * A_WIDTH, 3 * A_WIDTH + DIFF_QK_WIDTH,
            3 * A_WIDTH + 2 * DIFF_QK_WIDTH]
    qa, ka, va, qd, kd, vd = jnp.split(proj, cuts, axis=-1)
    qa = apply_rope(split_heads(qa, A_HEADS, HEAD_DIM), cos, sin)
    ka = apply_rope(split_heads(ka, A_HEADS, HEAD_DIM), cos, sin)
    oa = longnet_attention(qa, ka, split_heads(va, A_HEADS, HEAD_DIM))
    qd = apply_rope(split_heads(qd, 2 * DIFF_HEADS, HEAD_DIM), cos, sin)
    kd = apply_rope(split_heads(kd, 2 * DIFF_HEADS, HEAD_DIM), cos, sin)
    lp = lambda_params.astype(jnp.float32)
    lam = jnp.exp(jnp.sum(lp[0] * lp[1])) - jnp.exp(jnp.sum(lp[2] * lp[3])) + lambda_init
    od = differential_attention(qd, kd, split_heads(vd, DIFF_HEADS, DIFF_V_DIM), lam)
    od = rms_norm(od, subln_gain) * (1.0 - lambda_init)
    mixed = jnp.concatenate([merge_heads(oa), merge_heads(od).astype(h.dtype)], axis=-1)
    return mixed @ w_out


def hgrn2_chunkwise(q, k, v, log_f):
    b, h, s, kd = q.shape
    vd = v.shape[-1]
    n = s // HGRN_CHUNK

    def chunks(t):
        return t.reshape(b, h, n, HGRN_CHUNK, t.shape[-1]).transpose(2, 0, 1, 3, 4)

    causal = jnp.tril(jnp.ones((HGRN_CHUNK, HGRN_CHUNK), dtype=bool))[:, :, None]

    def step(state, inp):
        qc, kc, vc, gc = inp
        bcum = jnp.cumsum(gc, axis=2)
        inter = jnp.einsum('bhtk,bhkv->bhtv', qc * jnp.exp(bcum), state)
        diff = bcum[:, :, :, None, :] - bcum[:, :, None, :, :]
        decay = jnp.where(causal, jnp.exp(jnp.where(causal, diff, 0.0)), 0.0)
        attn = jnp.einsum('bhtk,bhsk,bhtsk->bhts', qc, kc, decay)
        intra = jnp.einsum('bhts,bhsv->bhtv', attn, vc)
        b_last = bcum[:, :, -1]
        state = jnp.exp(b_last)[..., None] * state + jnp.einsum(
            'bhsk,bhsv->bhkv', kc * jnp.exp(b_last[:, :, None, :] - bcum), vc)
        return state, inter + intra

    state0 = jnp.zeros((b, h, kd, vd), jnp.float32)
    _, out = lax.scan(step, state0, (chunks(q), chunks(k), chunks(v), chunks(log_f)))
    return out.transpose(1, 2, 0, 3, 4).reshape(b, h, s, vd)


def hgrn2_mixer(h, w_in, lower_bound, g_gain, w_out):
    b, s, _ = h.shape
    proj = h @ w_in
    q, f, i, g = jnp.split(proj, [HGRN_FORGET_WIDTH, 2 * HGRN_FORGET_WIDTH,
                                  2 * HGRN_FORGET_WIDTH + HGRN_VAL_WIDTH], axis=-1)
    forget = lower_bound + (1.0 - lower_bound) * jax.nn.sigmoid(f.astype(jnp.float32))
    log_f = jnp.log(forget)
    k = 1.0 - forget
    qf = jax.nn.silu(q.astype(jnp.float32)) * (HGRN_KEY_DIM ** -0.5)
    o = hgrn2_chunkwise(split_heads(qf, HGRN_HEADS, HGRN_KEY_DIM),
                        split_heads(k, HGRN_HEADS, HGRN_KEY_DIM),
                        split_heads(i.astype(jnp.float32), HGRN_HEADS, HGRN_VAL_DIM),
                        split_heads(log_f, HGRN_HEADS, HGRN_KEY_DIM))
    o = o.transpose(0, 2, 1, 3)
    gate = jax.nn.silu(g.astype(jnp.float32)).reshape(b, s, HGRN_HEADS, HGRN_VAL_DIM)
    o = rms_norm(o, g_gain) * gate
    return o.reshape(b, s, REC_MIX_WIDTH).astype(h.dtype) @ w_out


def swiglu_ffn(h, w_in, w_out):
    gate, up = jnp.split(h @ w_in, 2, axis=-1)
    return (jax.nn.silu(gate) * up) @ w_out


def setup_inputs(seed: int = 0) -> dict:
    key = jax.random.key(seed)
    ks = jax.random.split(key, 12)

    def dense(k, shape, fan_in):
        return jax.random.normal(k, shape, jnp.float32) * fan_in ** -0.5

    x = jax.random.normal(ks[0], (BATCH, SEQ, D_MODEL), jnp.float32)
    norm_gains = 1.0 + 0.05 * jax.random.normal(ks[1], (DEPTH, 4, D_MODEL), jnp.float32)
    att_w_in = dense(ks[2], (N_ATT_LAYERS, D_MODEL, ATT_IN_WIDTH), D_MODEL)
    att_lambda = 0.1 * jax.random.normal(ks[3], (N_ATT_LAYERS, 4, HEAD_DIM), jnp.float32)
    att_subln = 1.0 + 0.05 * jax.random.normal(ks[4], (N_ATT_LAYERS, DIFF_V_DIM), jnp.float32)
    att_w_out = dense(ks[5], (N_ATT_LAYERS, ATT_MIX_WIDTH, D_MODEL), ATT_MIX_WIDTH)
    rec_w_in = dense(ks[6], (N_REC_LAYERS, D_MODEL, REC_IN_WIDTH), D_MODEL)
    rec_lower_bounds = 0.5 * jax.random.normal(ks[7], (N_REC_LAYERS, HGRN_FORGET_WIDTH), jnp.float32)
    rec_gnorm = 1.0 + 0.05 * jax.random.normal(ks[8], (N_REC_LAYERS, HGRN_VAL_DIM), jnp.float32)
    rec_w_out = dense(ks[9], (N_REC_LAYERS, REC_MIX_WIDTH, D_MODEL), REC_MIX_WIDTH)
    ffn_w_in = dense(ks[10], (DEPTH, D_MODEL, 2 * FFN_HIDDEN), D_MODEL)
    ffn_w_out = dense(ks[11], (DEPTH, FFN_HIDDEN, D_MODEL), FFN_HIDDEN)
    return {'x': x, 'norm_gains': norm_gains, 'att_w_in': att_w_in, 'att_lambda': att_lambda,
            'att_subln': att_subln, 'att_w_out': att_w_out, 'rec_w_in': rec_w_in,
            'rec_lower_bounds': rec_lower_bounds, 'rec_gnorm': rec_gnorm, 'rec_w_out': rec_w_out,
            'ffn_w_in': ffn_w_in, 'ffn_w_out': ffn_w_out}


def reference(x, norm_gains, att_w_in, att_lambda, att_subln, att_w_out, rec_w_in,
              rec_lower_bounds, rec_gnorm, rec_w_out, ffn_w_in, ffn_w_out):
    cos, sin = rope_tables(x.shape[1], HEAD_DIM)
    lb_p = jax.nn.softmax(rec_lower_bounds.astype(jnp.float32), axis=0)
    lower_bounds = jnp.cumsum(lb_p, axis=0) - lb_p[0]
    for layer in range(DEPTH):
        gains = norm_gains[layer]
        j = layer // 2
        h = rms_norm(x, gains[0])
        if layer % 2 == 0:
            lambda_init = 0.8 - 0.6 * math.exp(-0.3 * layer)
            m = attention_mixer(h, att_w_in[j], att_lambda[j], att_subln[j], att_w_out[j],
                                lambda_init, cos, sin)
        else:
            m = hgrn2_mixer(h, rec_w_in[j], lower_bounds[j], rec_gnorm[j], rec_w_out[j])
        x = x + rms_norm(m, gains[1])
        h = rms_norm(x, gains[2])
        x = x + rms_norm(swiglu_ffn(h, ffn_w_in[layer], ffn_w_out[layer]), gains[3])
    return x
```

```cpp
#include <hip/hip_runtime.h>
#include <hip/hip_cooperative_groups.h>
#include <cstdio>
#include <cstdint>
namespace cg = cooperative_groups;

typedef unsigned short bf16_t;
typedef short bf16x8 __attribute__((ext_vector_type(8)));
typedef short s16x4 __attribute__((ext_vector_type(4)));
typedef float f32x16 __attribute__((ext_vector_type(16)));
typedef float f32x4 __attribute__((ext_vector_type(4)));
typedef unsigned u32x4 __attribute__((ext_vector_type(4)));
typedef unsigned u32x2 __attribute__((ext_vector_type(2)));
typedef __bf16 bf16x2_t __attribute__((ext_vector_type(2)));
typedef float f32x2_t __attribute__((ext_vector_type(2)));

#define DI __device__ __forceinline__
#define MFMA32(a, b, c) __builtin_amdgcn_mfma_f32_32x32x16_bf16((a), (b), (c), 0, 0, 0)

constexpr int NTHREADS = 512;
constexpr int M_TOK = 16384, DM = 1024, SEQ = 2048, NB = 8;
constexpr int ATT_IN = 3072, REC_IN = 4096, FFN_H = 2816, FFN_IN = 5632;
constexpr float EPS = 1e-6f;
constexpr float LOG2E = 1.4426950408889634f;
constexpr int LDS_BYTES = 131072 + 64;

constexpr size_t OFF_CTRL = 0;
constexpr size_t OFF_ROPE = 4096;
constexpr size_t OFF_WT = OFF_ROPE + 2 * 2048 * 32 * 4;
constexpr size_t N_ATT_IN_T = (size_t)2 * ATT_IN * DM;
constexpr size_t N_ATT_OUT_T = (size_t)2 * DM * DM;
constexpr size_t N_REC_IN_T = (size_t)2 * REC_IN * DM;
constexpr size_t N_REC_OUT_T = (size_t)2 * DM * DM;
constexpr size_t N_FFN_IN_T = (size_t)4 * FFN_IN * DM;
constexpr size_t N_FFN_OUT_T = (size_t)4 * DM * FFN_H;
constexpr size_t OFF_ATT_IN_T = OFF_WT;
constexpr size_t OFF_ATT_OUT_T = OFF_ATT_IN_T + N_ATT_IN_T * 2;
constexpr size_t OFF_REC_IN_T = OFF_ATT_OUT_T + N_ATT_OUT_T * 2;
constexpr size_t OFF_REC_OUT_T = OFF_REC_IN_T + N_REC_IN_T * 2;
constexpr size_t OFF_FFN_IN_T = OFF_REC_OUT_T + N_REC_OUT_T * 2;
constexpr size_t OFF_FFN_OUT_T = OFF_FFN_IN_T + N_FFN_IN_T * 2;
constexpr size_t OFF_HB = OFF_FFN_OUT_T + N_FFN_OUT_T * 2;
constexpr size_t OFF_P = OFF_HB + (size_t)M_TOK * DM * 2;
constexpr size_t OFF_T = OFF_P + (size_t)M_TOK * 4096 * 2;
constexpr size_t OFF_U = OFF_T + (size_t)M_TOK * DM * 4;
constexpr size_t OFF_D = OFF_U + (size_t)512 * 16384 * 2;
constexpr size_t OFF_BAR = OFF_D + (size_t)512 * 128 * 4;
constexpr size_t WS_NEED = OFF_BAR + 16384;

struct Params {
    const float* x; const float* norm_gains; const float* att_w_in; const float* att_lambda; const float* att_subln;
    const float* att_w_out; const float* rec_w_in; const float* rec_lb; const float* rec_gnorm; const float* rec_w_out;
    const float* ffn_w_in; const float* ffn_w_out;
    float* out; unsigned char* ws;
    int ph_lo, ph_hi;
    int wave, pad0;
};

DI int obid() { int b = blockIdx.x; asm volatile("" : "+s"(b)); return b; }
DI int ogrid() { int g = gridDim.x; asm volatile("" : "+s"(g)); return g; }
DI int olane() { int l; asm volatile("v_mbcnt_lo_u32_b32 %0, -1, 0\n\tv_mbcnt_hi_u32_b32 %0, -1, %0" : "=v"(l)); return l; }
DI int otid_w(int gw) { return (gw << 6) | olane(); }
DI unsigned pk_bf16(float a, float b) { f32x2_t v = {a, b}; bf16x2_t r = __builtin_convertvector(v, bf16x2_t); return __builtin_bit_cast(unsigned, r); }
DI float bf2f(bf16_t u) { return __uint_as_float(((unsigned)u) << 16); }
DI bf16_t f2bf(float a) { return (bf16_t)(pk_bf16(a, 0.f) & 0xffffu); }
DI int crow(int i, int h) { return (i & 3) + 8 * (i >> 2) + 4 * h; }
DI float shx(float v, int mask) { const int l = olane(); return __builtin_bit_cast(float, __builtin_amdgcn_ds_bpermute(((l ^ mask) & 63) << 2, __builtin_bit_cast(int, v))); }
DI float oconst(float c) { asm volatile("" : "+v"(c)); return c; }
DI float uni(float x) { return __builtin_bit_cast(float, __builtin_amdgcn_readfirstlane(__builtin_bit_cast(int, x))); }
DI float wave_sum(float v) {
#pragma unroll
    for (int o = 32; o >= 1; o >>= 1) v += shx(v, o);
    return v;
}
DI float silu_f(float x) { return x * __builtin_amdgcn_rcpf(1.f + __expf(-x)); }
DI bf16x8 pack8(const f32x16& x, int s) {
    u32x4 p;
    p[0] = pk_bf16(x[8 * s + 0], x[8 * s + 1]); p[1] = pk_bf16(x[8 * s + 2], x[8 * s + 3]);
    p[2] = pk_bf16(x[8 * s + 4], x[8 * s + 5]); p[3] = pk_bf16(x[8 * s + 6], x[8 * s + 7]);
    return __builtin_bit_cast(bf16x8, p);
}
DI bf16x8 ld_b64x2(const bf16_t* p0, const bf16_t* p1) {
    u32x2 a = *(const u32x2*)p0, b = *(const u32x2*)p1;
    u32x4 r; r[0] = a[0]; r[1] = a[1]; r[2] = b[0]; r[3] = b[1];
    return __builtin_bit_cast(bf16x8, r);
}

DI void transpose_tiles(const float* src, bf16_t* dst, int K, int N, bool perm, int& tile_base, char* lds, const int gw, const int vbid, const int vgrid) {
    const int tid512 = otid_w(gw), half = tid512 >> 8, tid = tid512 & 255;
    float* tl = (float*)lds + half * (64 * 65);
    const int tk = K / 64, tn = N / 64, nt = tk * tn;
    const int vb = vbid * 2 + half, nvb = vgrid * 2;
    int first = (vb - tile_base) % nvb; if (first < 0) first += nvb;
    const int iters = (nt + nvb - 1) / nvb;
    f32x4 rv[4];
#define TT_LOAD(T) do { if ((T) < nt) { const int kb_ = ((T) % tk) * 64, nb_ = ((T) / tk) * 64; \
        _Pragma("unroll") for (int i = 0; i < 4; ++i) { const int kl = (tid >> 4) + 16 * i, np = nb_ + (tid & 15) * 4; \
            const int nq = (np & ~255) | (((np >> 5) & 3) << 6) | (((np >> 7) & 1) << 5) | (np & 31);     \
            const int sc = perm ? (((nq >> 5) & 1) * FFN_H + (nq >> 6) * 32 + (nq & 31)) : nq; \
            rv[i] = *(const f32x4*)(src + (size_t)(kb_ + kl) * N + sc); } } } while (0)
    TT_LOAD(first);
    for (int it = 0; it < iters; ++it) {
        const int t = first + it * nvb; const bool act = t < nt;
        const int kb = (t % tk) * 64, nb = (t / tk) * 64;
        __syncthreads();
        if (act) {
#pragma unroll
            for (int i = 0; i < 4; ++i) { const int kl = (tid >> 4) + 16 * i, n4 = (tid & 15) * 4;
                tl[kl * 65 + n4 + 0] = rv[i][0]; tl[kl * 65 + n4 + 1] = rv[i][1]; tl[kl * 65 + n4 + 2] = rv[i][2]; tl[kl * 65 + n4 + 3] = rv[i][3]; }
        }
        __syncthreads();
        TT_LOAD(t + nvb);
        if (act) {
            const int nl = tid >> 2, ks = (tid & 3) * 16;
            u32x4 o0, o1;
#pragma unroll
            for (int j = 0; j < 4; ++j) {
                o0[j] = pk_bf16(tl[(ks + 2 * j) * 65 + nl], tl[(ks + 2 * j + 1) * 65 + nl]);
                o1[j] = pk_bf16(tl[(ks + 8 + 2 * j) * 65 + nl], tl[(ks + 8 + 2 * j + 1) * 65 + nl]);
            }
            bf16_t* d = dst + (size_t)(nb + nl) * K + kb + ks;
            *(u32x4*)d = o0; *(u32x4*)(d + 8) = o1;
        }
    }
#undef TT_LOAD
    tile_base = (tile_base + nt) % nvb;
}

DI void row_phase(const bf16_t* msrc, const float* xsrc, float* xdst, const float* g_post, const float* g_next, bf16_t* hdst, const int gw) {
    constexpr int RB = 4;
    const int tid = otid_w(gw); const int lane = tid & 63, w = tid >> 6;
    const int wg = obid() * 8 + w, nw = ogrid() * 8;
    for (int rowb = wg * RB; rowb < M_TOK; rowb += nw * RB) {
        f32x4 xv[RB][4], mv[RB][4];
#pragma unroll
        for (int r = 0; r < RB; ++r)
#pragma unroll
            for (int j = 0; j < 4; ++j) xv[r][j] = *(const f32x4*)(xsrc + (size_t)(rowb + r) * DM + lane * 4 + 256 * j);
        if (msrc) {
#pragma unroll
            for (int r = 0; r < RB; ++r)
#pragma unroll
                for (int j = 0; j < 4; ++j) { const u32x2 mw = *(const u32x2*)(msrc + (size_t)(rowb + r) * DM + lane * 4 + 256 * j);
                    mv[r][j] = (f32x4){__uint_as_float(mw[0] << 16), __uint_as_float(mw[0] & 0xffff0000u), __uint_as_float(mw[1] << 16), __uint_as_float(mw[1] & 0xffff0000u)}; }
            float ss[RB];
#pragma unroll
            for (int r = 0; r < RB; ++r) { ss[r] = 0.f;
#pragma unroll
                for (int j = 0; j < 4; ++j) ss[r] += mv[r][j][0] * mv[r][j][0] + mv[r][j][1] * mv[r][j][1] + mv[r][j][2] * mv[r][j][2] + mv[r][j][3] * mv[r][j][3]; }
#pragma unroll
            for (int o = 32; o >= 1; o >>= 1)
#pragma unroll
                for (int r = 0; r < RB; ++r) ss[r] += shx(ss[r], o);
#pragma unroll
            for (int j = 0; j < 4; ++j) { const f32x4 g = *(const f32x4*)(g_post + lane * 4 + 256 * j);
#pragma unroll
                for (int r = 0; r < RB; ++r) { const float r1 = rsqrtf(ss[r] * (1.f / DM) + EPS); xv[r][j] = xv[r][j] + mv[r][j] * r1 * g; *(f32x4*)(xdst + (size_t)(rowb + r) * DM + lane * 4 + 256 * j) = xv[r][j]; } }
        }
        if (hdst) {
            float ss[RB];
#pragma unroll
            for (int r = 0; r < RB; ++r) { ss[r] = 0.f;
#pragma unroll
                for (int j = 0; j < 4; ++j) ss[r] += xv[r][j][0] * xv[r][j][0] + xv[r][j][1] * xv[r][j][1] + xv[r][j][2] * xv[r][j][2] + xv[r][j][3] * xv[r][j][3]; }
#pragma unroll
            for (int o = 32; o >= 1; o >>= 1)
#pragma unroll
                for (int r = 0; r < RB; ++r) ss[r] += shx(ss[r], o);
#pragma unroll
            for (int j = 0; j < 4; ++j) { const f32x4 g = *(const f32x4*)(g_next + lane * 4 + 256 * j);
#pragma unroll
                for (int r = 0; r < RB; ++r) { const float r2 = rsqrtf(ss[r] * (1.f / DM) + EPS); const f32x4 hv = xv[r][j] * r2 * g;
                    u32x2 o; o[0] = pk_bf16(hv[0], hv[1]); o[1] = pk_bf16(hv[2], hv[3]); *(u32x2*)(hdst + (size_t)(rowb + r) * DM + lane * 4 + 256 * j) = o; } }
        }
    }
}

DI void convert_layer_weights(const Params& p, const int L, const int vbid, const int vgrid, char* lds, const int which  ) {
    unsigned char* ws = p.ws;
    const int j = L >> 1;
    int tb = 0;
    if ((which & 1) == 0) {
    } else if ((L & 1) == 0) {
        transpose_tiles(p.att_w_in + (size_t)j * DM * ATT_IN, (bf16_t*)(ws + OFF_ATT_IN_T) + (size_t)j * ATT_IN * DM, DM, ATT_IN, false, tb, lds, p.wave, vbid, vgrid);
        transpose_tiles(p.att_w_out + (size_t)j * DM * DM, (bf16_t*)(ws + OFF_ATT_OUT_T) + (size_t)j * DM * DM, DM, DM, false, tb, lds, p.wave, vbid, vgrid);
    } else {
        transpose_tiles(p.rec_w_in + (size_t)j * DM * REC_IN, (bf16_t*)(ws + OFF_REC_IN_T) + (size_t)j * REC_IN * DM, DM, REC_IN, false, tb, lds, p.wave, vbid, vgrid);
        transpose_tiles(p.rec_w_out + (size_t)j * DM * DM, (bf16_t*)(ws + OFF_REC_OUT_T) + (size_t)j * DM * DM, DM, DM, false, tb, lds, p.wave, vbid, vgrid);
    }
    if (which & 2) {
    transpose_tiles(p.ffn_w_in + (size_t)L * DM * FFN_IN, (bf16_t*)(ws + OFF_FFN_IN_T) + (size_t)L * FFN_IN * DM, DM, FFN_IN, true, tb, lds, p.wave, vbid, vgrid);
    transpose_tiles(p.ffn_w_out + (size_t)L * FFN_H * DM, (bf16_t*)(ws + OFF_FFN_OUT_T) + (size_t)L * DM * FFN_H, FFN_H, DM, false, tb, lds, p.wave, vbid, vgrid);
    }
}

DI void prep_phase(const Params& p, char* lds) {
    unsigned char* ws = p.ws;
    const int ptid = otid_w(p.wave);
    if (obid() == 0 && ptid < 64) ((unsigned*)(ws + OFF_CTRL))[ptid] = 0u;
    {
        float* cosT = (float*)(ws + OFF_ROPE); float* sinT = cosT + 2048 * 32;
        for (int idx = obid() * NTHREADS + ptid; idx < 2048 * 32; idx += ogrid() * NTHREADS) {
            const int pos = idx >> 5, i = idx & 31;
            const float inv_freq = __builtin_amdgcn_exp2f(-(float)i * (13.287712379549449f / 32.f));
            const float ang = (float)pos * inv_freq;
            const float n = rintf(ang * 0.15915494309189535f);
            float r = fmaf(-n, 6.28125f, ang); r = fmaf(-n, 1.9353071795864769e-3f, r);
            const float rev = r * 0.15915494309189535f;
            cosT[idx] = __builtin_amdgcn_cosf(rev); sinT[idx] = __builtin_amdgcn_sinf(rev);
        }
    }
    convert_layer_weights(p, 0, obid(), ogrid(), lds, 3);
    for (int L = 1; L < 4; ++L) convert_layer_weights(p, L, obid(), ogrid(), lds, 1);
    row_phase(nullptr, p.x, nullptr, nullptr, p.norm_gains, (bf16_t*)(ws + OFF_HB), p.wave);
}

enum { EPI_F32 = 0, EPI_ATT_IN = 1, EPI_REC_IN = 2, EPI_FFN_IN = 3 };
constexpr int LDK = 72;

DI int lds_byte(int r, int c) { const int st = (r >> 4) * 2 + (c >> 5), ob = (r & 15) * 64 + (c & 31) * 2; return st * 1024 + (ob ^ (((ob >> 9) & 1) << 5)); }
DI void stage_rc(int b, int& R, int& C) { const int st = b >> 10, sb = b & 1023, swz = sb ^ (((sb >> 9) & 1) << 5); R = (st / 2) * 16 + swz / 64; C = (st % 2) * 32 + (swz % 64) / 2; }

#define LAS3 __attribute__((address_space(3)))
template <int EPI>
DI void gemm_phase(const bf16_t* __restrict__ A, const bf16_t* __restrict__ Bt, const int K, const int N, const Params& p, const int layer_j, char* lds) {
    const int wid = p.wave;
    const int lane = olane(), wr = wid >> 2, wc = wid & 3;
    constexpr int HTB = 128 * 64 * 2, NXCD = 8, WGM = 1, HALF = 128;
    const int nM = M_TOK / 256, nN = N / 256, nwg = nM * nN, nt = K / 64;
    unsigned char* ws = p.ws;
    LAS3 char* L = (LAS3 char*)lds;
    int stoff = (wid * 64 + lane) * 16;
    int aoff = lds_byte(wr * 64 + (lane & 15), (lane >> 4) * 8), boff = lds_byte(wc * 32 + (lane & 15), (lane >> 4) * 8);
    asm volatile("" : "+v"(stoff), "+v"(aoff), "+v"(boff));
#define SA(b, h) (((b) * 2 + (h)) * HTB)
#define SB(b, h) ((4 + (b) * 2 + (h)) * HTB)
#define STAGE(bufoff, GB) do { const char* g_ = (GB); \
        _Pragma("unroll") for (int i_ = 0; i_ < 2; ++i_) __builtin_amdgcn_global_load_lds((const unsigned*)(g_ + voff[i_]), (LAS3 unsigned*)(L + (bufoff) + stoff + i_ * 8192), 16, 0, 0); } while (0)
#define LDA(dst, b, h) do { _Pragma("unroll") for (int m = 0; m < 4; ++m) _Pragma("unroll") for (int k = 0; k < 2; ++k) dst[m][k] = *(const LAS3 bf16x8*)(L + SA(b, h) + aoff + m * 2048 + k * 1024); } while (0)
#define LDB(dst, b, h) do { _Pragma("unroll") for (int n = 0; n < 2; ++n) _Pragma("unroll") for (int k = 0; k < 2; ++k) dst[n][k] = *(const LAS3 bf16x8*)(L + SB(b, h) + boff + n * 2048 + k * 1024); } while (0)
#define MMA(ai, bj, At_, Bt_) do { __builtin_amdgcn_s_setprio(1); _Pragma("unroll") for (int m = 0; m < 4; ++m) _Pragma("unroll") for (int n = 0; n < 2; ++n) _Pragma("unroll") for (int k = 0; k < 2; ++k) \
        acc[ai][bj][m][n] = __builtin_amdgcn_mfma_f32_16x16x32_bf16(At_[m][k], Bt_[n][k], acc[ai][bj][m][n], 0, 0, 0); __builtin_amdgcn_s_setprio(0); } while (0)
#define WAIT_V(n) asm volatile("s_waitcnt vmcnt(" #n ")" ::: "memory")
#define WAIT_L(n) asm volatile("s_waitcnt lgkmcnt(" #n ")" ::: "memory")
#define BAR __builtin_amdgcn_s_barrier()
#define SCHED __builtin_amdgcn_sched_barrier(0)
#define TILE_COORDS(LID, PM, PN) do { int wgid_ = (LID); \
        { const int q_ = nwg / NXCD, r_ = nwg % NXCD, xcd_ = wgid_ % NXCD, off_ = wgid_ / NXCD; wgid_ = (xcd_ < r_ ? xcd_ * (q_ + 1) : r_ * (q_ + 1) + (xcd_ - r_) * q_) + off_; } \
        const int nig_ = WGM * nN, gid_ = wgid_ / nig_, fm_ = gid_ * WGM, gsz_ = (nM - fm_) < WGM ? (nM - fm_) : WGM; \
        PM = fm_ + ((wgid_ % nig_) % gsz_); PN = (wgid_ % nig_) / gsz_; } while (0)
#define VOFF_INIT() do { _Pragma("unroll") for (int i = 0; i < 2; ++i) { int R, C; stage_rc((wid * 64 + olane()) * 16 + i * 8192, R, C); voff[i] = (unsigned)(R * K + C) * 2u; } } while (0)
    if (obid() >= nwg) return;
    int pm, pn;
    TILE_COORDS(obid(), pm, pn);
    const size_t kstep = 128, hstep = (size_t)HALF * K * 2, tstep = 2 * hstep;
    const char* cA = (const char*)A + (size_t)pm * tstep; const char* cB = (const char*)Bt + (size_t)pn * tstep;
    f32x4 acc[2][2][4][2];
#pragma unroll
    for (int a = 0; a < 2; ++a)
#pragma unroll
        for (int b = 0; b < 2; ++b)
#pragma unroll
            for (int m = 0; m < 4; ++m)
#pragma unroll
                for (int n = 0; n < 2; ++n) acc[a][b][m][n] = (f32x4){0.f, 0.f, 0.f, 0.f};
    bf16x8 At[4][2], B0[2][2], B1[2][2];
    {
        unsigned voff[2]; VOFF_INIT();
        asm volatile("s_waitcnt vmcnt(0) lgkmcnt(0)" ::: "memory");
        __syncthreads();
        STAGE(SB(0, 0), cB); STAGE(SB(0, 1), cB + hstep); STAGE(SA(0, 0), cA); STAGE(SA(0, 1), cA + hstep);
        if (wr == 1) BAR;
        WAIT_V(2); BAR;
        STAGE(SB(1, 0), cB + kstep); STAGE(SA(1, 0), cA + kstep); STAGE(SB(1, 1), cB + hstep + kstep);
        WAIT_V(6); BAR;
    }
    for (int ui = 0;; ++ui) {
        const int Lnext = (ui + 1) * ogrid() + obid();
        const bool has_next = Lnext < nwg;
        int pm2 = pm, pn2 = pn;
        if (has_next) TILE_COORDS(Lnext, pm2, pn2);
        const char* nA = (const char*)A + (size_t)pm2 * tstep; const char* nB = (const char*)Bt + (size_t)pn2 * tstep;
        unsigned voff[2]; VOFF_INIT();
        for (int t = 0; t < nt; t += 2) {
            const bool last = (t == nt - 2);
            const char* a1 = cA + (size_t)(t + 1) * kstep;
            const char* a2 = last ? nA : cA + (size_t)(t + 2) * kstep; const char* b2 = last ? nB : cB + (size_t)(t + 2) * kstep;
            const char* a3 = a2 + kstep; const char* b3 = b2 + kstep;
            LDB(B0, 0, 0); LDB(B1, 0, 1); SCHED; LDA(At, 0, 0); STAGE(SA(1, 1), a1 + hstep);
            WAIT_V(8); WAIT_L(0); BAR; MMA(0, 0, At, B0); MMA(0, 1, At, B1); BAR; SCHED;
            LDA(At, 0, 1); STAGE(SB(0, 0), b2); STAGE(SB(0, 1), b2 + hstep); STAGE(SA(0, 0), a2);
            WAIT_V(8); WAIT_L(0); BAR; MMA(1, 0, At, B0); MMA(1, 1, At, B1); BAR; SCHED;
            LDB(B0, 1, 0); LDB(B1, 1, 1); SCHED; LDA(At, 1, 0); STAGE(SA(0, 1), a2 + hstep);
            WAIT_V(8); WAIT_L(0); BAR; MMA(0, 0, At, B0); MMA(0, 1, At, B1); BAR; SCHED;
            LDA(At, 1, 1); STAGE(SB(1, 0), b3); STAGE(SB(1, 1), b3 + hstep); STAGE(SA(1, 0), a3);
            WAIT_V(8); WAIT_L(0); BAR; MMA(1, 0, At, B0); MMA(1, 1, At, B1); BAR; SCHED;
        }
        if (wr == 0) BAR;
        const int le = olane(), fr = le & 15, fq = le >> 4;
        const int row0 = pm * 256 + wr * 64 + fq * 4;
        const int col0 = pn * 256 + wc * 64;
        if (EPI == EPI_F32) {
            bf16_t* T = (bf16_t*)(ws + OFF_T) + (size_t)row0 * DM + col0 + fr;
#pragma unroll
            for (int ai = 0; ai < 2; ++ai)
#pragma unroll
                for (int m = 0; m < 4; ++m)
#pragma unroll
                    for (int j = 0; j < 4; ++j)
#pragma unroll
                        for (int bj = 0; bj < 2; ++bj)
#pragma unroll
                            for (int n = 0; n < 2; ++n) T[(size_t)(ai * 128 + m * 16 + j) * DM + bj * 32 + n * 16] = f2bf(acc[ai][bj][m][n][j]);
        } else if (EPI == EPI_FFN_IN) {
            bf16_t* HID = (bf16_t*)(ws + OFF_P) + (size_t)row0 * FFN_H + (col0 >> 1) + fr;
#pragma unroll
            for (int ai = 0; ai < 2; ++ai)
#pragma unroll
                for (int m = 0; m < 4; ++m)
#pragma unroll
                    for (int j = 0; j < 4; ++j)
#pragma unroll
                        for (int n = 0; n < 2; ++n) HID[(size_t)(ai * 128 + m * 16 + j) * FFN_H + n * 16] = f2bf(silu_f(acc[ai][0][m][n][j]) * acc[ai][1][m][n][j]);
        } else if (EPI == EPI_ATT_IN) {
            bf16_t* PROJ = (bf16_t*)(ws + OFF_P);
            bf16_t* VT = PROJ + (size_t)M_TOK * ATT_IN;
            const int region = col0 >> 9;
            if (region == 2 || region == 5) {
                const int vc0 = (region == 2 ? col0 - 1024 : 512 + col0 - 2560);
                const int b = row0 >> 11, t0 = row0 & 2047;
                bf16_t* dst = VT + ((size_t)(b * 1024 + vc0 + fr)) * SEQ + t0;
#pragma unroll
                for (int bj = 0; bj < 2; ++bj)
#pragma unroll
                    for (int n = 0; n < 2; ++n)
#pragma unroll
                        for (int ai = 0; ai < 2; ++ai)
#pragma unroll
                            for (int m = 0; m < 4; ++m) { u32x2 o; o[0] = pk_bf16(acc[ai][bj][m][n][0], acc[ai][bj][m][n][1]); o[1] = pk_bf16(acc[ai][bj][m][n][2], acc[ai][bj][m][n][3]);
                                *(u32x2*)(dst + (size_t)(bj * 32 + n * 16) * SEQ + ai * 128 + m * 16) = o; }
            } else {
                const float sc = (region == 0 || region == 3) ? 0.125f * LOG2E : 1.0f;
                const float* cb = (const float*)(ws + OFF_ROPE) + (row0 & 2047) * 32 + fr;
                bf16_t* dst = PROJ + (size_t)row0 * ATT_IN + col0 + fr;
#pragma unroll
                for (int ai = 0; ai < 2; ++ai)
#pragma unroll
                    for (int m = 0; m < 4; ++m)
#pragma unroll
                        for (int j = 0; j < 4; ++j)
#pragma unroll
                            for (int n = 0; n < 2; ++n) {
                                const int ro = ai * 128 + m * 16 + j;
                                const float c = cb[ro * 32 + n * 16], sn = cb[2048 * 32 + ro * 32 + n * 16];
                                const float x1 = acc[ai][0][m][n][j], x2 = acc[ai][1][m][n][j];
                                dst[(size_t)ro * ATT_IN + n * 16] = f2bf((x1 * c - x2 * sn) * sc); dst[(size_t)ro * ATT_IN + 32 + n * 16] = f2bf((x2 * c + x1 * sn) * sc);
                                if (n == 1 && (j & 1)) __builtin_amdgcn_sched_barrier(0); }
            }
        } else if (EPI == EPI_REC_IN) {
            bf16_t* PROJ = (bf16_t*)(ws + OFF_P);
            bf16_t* IT = PROJ + (size_t)M_TOK * ATT_IN;
            const int region = col0 >> 10;
            if (region == 2) {
                const int vc0 = col0 - 2048;
                const int b = row0 >> 11, t0 = row0 & 2047;
                bf16_t* dst = IT + ((size_t)(b * 1024 + vc0 + fr)) * SEQ + t0;
#pragma unroll
                for (int bj = 0; bj < 2; ++bj)
#pragma unroll
                    for (int n = 0; n < 2; ++n)
#pragma unroll
                        for (int ai = 0; ai < 2; ++ai)
#pragma unroll
                            for (int m = 0; m < 4; ++m) { u32x2 o; o[0] = pk_bf16(acc[ai][bj][m][n][0], acc[ai][bj][m][n][1]); o[1] = pk_bf16(acc[ai][bj][m][n][2], acc[ai][bj][m][n][3]);
                                *(u32x2*)(dst + (size_t)(bj * 32 + n * 16) * SEQ + ai * 128 + m * 16) = o; }
            } else if (region == 1) {
                float* lf = (float*)(ws + OFF_T) + (size_t)row0 * DM + (col0 - 1024) + fr;
                bf16_t* dst = PROJ + (size_t)row0 * ATT_IN + col0 + fr;
#pragma unroll
                for (int bj = 0; bj < 2; ++bj)
#pragma unroll
                    for (int n = 0; n < 2; ++n) {
                        float lb = 0.f;
                        if (layer_j == 1) { const float a0 = p.rec_lb[col0 - 1024 + bj * 32 + n * 16 + fr], a1 = p.rec_lb[DM + col0 - 1024 + bj * 32 + n * 16 + fr]; lb = 1.f / (1.f + __expf(a0 - a1)); }
#pragma unroll
                        for (int ai = 0; ai < 2; ++ai)
#pragma unroll
                            for (int m = 0; m < 4; ++m)
#pragma unroll
                                for (int j = 0; j < 4; ++j) {
                                    const float sg = __builtin_amdgcn_rcpf(1.f + __expf(-acc[ai][bj][m][n][j])); const float fg = lb + (1.f - lb) * sg;
                                    lf[(size_t)(ai * 128 + m * 16 + j) * DM + bj * 32 + n * 16] = __logf(fg);
                                    dst[(size_t)(ai * 128 + m * 16 + j) * ATT_IN + bj * 32 + n * 16] = f2bf(1.f - fg);
                                    if (j == 3) __builtin_amdgcn_sched_barrier(0); } }
            } else {
                const int dc0 = (region == 0) ? col0 : (col0 - 3072 + 2048);
                const float sc = (region == 0) ? 0.08838834764831845f : 1.0f;
                bf16_t* dst = PROJ + (size_t)row0 * ATT_IN + dc0 + fr;
#pragma unroll
                for (int ai = 0; ai < 2; ++ai)
#pragma unroll
                    for (int m = 0; m < 4; ++m)
#pragma unroll
                        for (int j = 0; j < 4; ++j)
#pragma unroll
                            for (int bj = 0; bj < 2; ++bj)
#pragma unroll
                                for (int n = 0; n < 2; ++n) dst[(size_t)(ai * 128 + m * 16 + j) * ATT_IN + bj * 32 + n * 16] = f2bf(silu_f(acc[ai][bj][m][n][j]) * sc);
            }
        }
        if (!has_next) break;
#pragma unroll
        for (int a = 0; a < 2; ++a)
#pragma unroll
            for (int b = 0; b < 2; ++b)
#pragma unroll
                for (int m = 0; m < 4; ++m)
#pragma unroll
                    for (int n = 0; n < 2; ++n) acc[a][b][m][n] = (f32x4){0.f, 0.f, 0.f, 0.f};
        pm = pm2; pn = pn2; cA = nA; cB = nB;
        if (wr == 1) BAR;
    }
    WAIT_V(0);
    BAR;
#undef TILE_COORDS
#undef VOFF_INIT
#undef SA
#undef SB
#undef STAGE
#undef LDA
#undef LDB
#undef MMA
}

template <int DV, bool MULT>
DI void attn_pass(const bf16_t* __restrict__ Kg, const bf16_t* __restrict__ VTg, const bf16x8 (&qf)[4], const int q0, f32x16 (&O)[DV / 32], float& m_run, float& l_run, char* lds, const int gw) {
    const int tid = otid_w(gw), lane = tid & 63, w = tid >> 6, l31 = lane & 31, hh = lane >> 5;
    constexpr int LDV = 132;
    bf16_t* Ks = (bf16_t*)lds;
    bf16_t* Vs = Ks + 128 * LDK;
    constexpr int NV = DV / 32;
    const int nkt = (q0 + 256) / 128;
    const int qpos = q0 + w * 32 + l31;
    const int qhi = q0 + w * 32 + 31, q0w = q0 + w * 32;
    float adjF[16], adjM[16];
    if (MULT) {
#pragma unroll
        for (int i = 0; i < 16; ++i) { const int d = (l31 - crow(i, hh)) & 15; adjF[i] = (d == 0) ? 0.f : -1e30f; adjM[i] = ((d & 3) == 0) ? ((d == 0) ? 1.f : 0.f) : -1e30f; }
    }
    u32x4 rk[2], rv[NV];
#pragma unroll
    for (int i = 0; i < 2; ++i) { const int c = tid + 512 * i, key = c >> 3, d8 = c & 7; rk[i] = *(const u32x4*)(Kg + (size_t)key * ATT_IN + d8 * 8); }
#pragma unroll
    for (int i = 0; i < NV; ++i) { const int c = tid + 512 * i, dv = c >> 4, k8 = c & 15; rv[i] = *(const u32x4*)(VTg + (size_t)dv * SEQ + k8 * 8); }
    for (int kt = 0; kt < nkt; ++kt) {
        const int kb0 = kt * 128;
        __syncthreads();
#pragma unroll
        for (int i = 0; i < 2; ++i) { const int c = tid + 512 * i, key = c >> 3, d8 = c & 7; *(u32x4*)(Ks + key * LDK + d8 * 8) = rk[i]; }
#pragma unroll
        for (int i = 0; i < NV; ++i) { const int c = tid + 512 * i, dv = c >> 4, k8 = c & 15; u32x2 lo_, hi_; lo_[0] = rv[i][0]; lo_[1] = rv[i][1]; hi_[0] = rv[i][2]; hi_[1] = rv[i][3];
            *(u32x2*)(Vs + dv * LDV + k8 * 8) = lo_; *(u32x2*)(Vs + dv * LDV + k8 * 8 + 4) = hi_; }
        __syncthreads();
        if (kt + 1 < nkt) {
#pragma unroll
            for (int i = 0; i < 2; ++i) { const int c = tid + 512 * i, key = c >> 3, d8 = c & 7; rk[i] = *(const u32x4*)(Kg + (size_t)(kb0 + 128 + key) * ATT_IN + d8 * 8); }
#pragma unroll
            for (int i = 0; i < NV; ++i) { const int c = tid + 512 * i, dv = c >> 4, k8 = c & 15; rv[i] = *(const u32x4*)(VTg + (size_t)dv * SEQ + kb0 + 128 + k8 * 8); }
        }
#pragma unroll 1
        for (int hf = 0; hf < 2; ++hf) {
        const int kb = kb0 + hf * 64;
        const bf16_t* Kh = Ks + hf * 64 * LDK;
        const bf16_t* Vh = Vs + hf * 64;
        if (kb <= qhi) {
            f32x16 st[2];
#pragma unroll
            for (int k2 = 0; k2 < 2; ++k2) {
#pragma unroll
                for (int i = 0; i < 16; ++i) st[k2][i] = 0.f;
#pragma unroll
                for (int ks = 0; ks < 4; ++ks) { const bf16x8 a = *(const bf16x8*)(Kh + (32 * k2 + l31) * LDK + ks * 16 + 8 * hh); st[k2] = MFMA32(a, qf[ks], st[k2]); }
            }
            float mx = -1e30f;
            const bool zfar = MULT && (kb + 63 + 512 < q0w);
            const bool zmid = MULT && !zfar && (q0w - (kb + 63) > 128) && (q0w + 31 - kb <= 512);
            const bool zfree = !MULT && (kb + 63 <= q0w);
            if (zfar) {
#pragma unroll
                for (int k2 = 0; k2 < 2; ++k2)
#pragma unroll
                    for (int i = 0; i < 16; ++i) { const float sv = st[k2][i] + adjF[i]; st[k2][i] = sv; mx = fmaxf(mx, sv); }
            } else if (zmid) {
#pragma unroll
                for (int k2 = 0; k2 < 2; ++k2)
#pragma unroll
                    for (int i = 0; i < 16; ++i) { const float sv = st[k2][i] + adjM[i]; st[k2][i] = sv; mx = fmaxf(mx, sv); }
            } else if (zfree) {
#pragma unroll
                for (int k2 = 0; k2 < 2; ++k2)
#pragma unroll
                    for (int i = 0; i < 16; ++i) mx = fmaxf(mx, st[k2][i]);
            } else {
#pragma unroll
                for (int k2 = 0; k2 < 2; ++k2)
#pragma unroll
                    for (int i = 0; i < 16; ++i) {
                        const int key = kb + 32 * k2 + crow(i, hh); const int dl = qpos - key;
                        float sv;
                        if (MULT) {
                            const int c = (dl >= 0) ? ((dl <= 128 ? 1 : 0) + (((dl & 3) == 0 && dl <= 512) ? 1 : 0) + (((dl & 15) == 0) ? 1 : 0)) : 0;
                            const float adj = (c == 3) ? 1.5849625007211562f : ((c == 2) ? 1.0f : 0.0f);
                            sv = (c > 0) ? st[k2][i] + adj : -1e30f;
                        } else {
                            sv = (dl >= 0) ? st[k2][i] : -1e30f;
                        }
                        st[k2][i] = sv; mx = fmaxf(mx, sv);
                    }
            }
            mx = fmaxf(mx, shx(mx, 32));
            const float m_new = fmaxf(m_run, mx);
            if (__builtin_amdgcn_ballot_w64(m_new > m_run + 8.0f) != 0ull) {
                const float alpha = __builtin_amdgcn_exp2f(m_run - m_new);
                m_run = m_new; l_run *= alpha;
#pragma unroll
                for (int dt = 0; dt < DV / 32; ++dt)
#pragma unroll
                    for (int i = 0; i < 16; ++i) O[dt][i] *= alpha;
            }
            float ps = 0.f;
#pragma unroll
            for (int k2 = 0; k2 < 2; ++k2)
#pragma unroll
                for (int i = 0; i < 16; ++i) { const float pe = __builtin_amdgcn_exp2f(st[k2][i] - m_run); st[k2][i] = pe; ps += pe; }
            l_run += ps;
#pragma unroll
            for (int ks2 = 0; ks2 < 4; ++ks2) {
                const bf16x8 pb = pack8(st[ks2 >> 1], ks2 & 1);
#pragma unroll
                for (int dt = 0; dt < DV / 32; ++dt) {
                    const bf16_t* vp = Vh + (32 * dt + l31) * LDV + 16 * ks2 + 4 * hh;
                    const bf16x8 a = ld_b64x2(vp, vp + 8);
                    O[dt] = MFMA32(a, pb, O[dt]);
                }
            }
        }
        }
    }
}

DI void attn_phase(const Params& p, const int j, char* lds, const int cidx) {
    unsigned char* ws = p.ws;
    const bf16_t* PROJ = (const bf16_t*)(ws + OFF_P);
    const bf16_t* VT = PROJ + (size_t)M_TOK * ATT_IN;
    bf16_t* MIX = (bf16_t*)(ws + OFF_HB);
    unsigned* counter = (unsigned*)(ws + OFF_CTRL) + cidx;
    int* s_item = (int*)(lds + LDS_BYTES - 16);
    const int tid = otid_w(p.wave), lane = tid & 63, w = tid >> 6, l31 = lane & 31, hh = lane >> 5;
    const float lambda_init = (j == 0) ? 0.2f : 0.4707130183435842f;
    float lam;
    {
        const float* lp = p.att_lambda + (size_t)j * 4 * 64;
        const float sa = wave_sum(lp[lane] * lp[64 + lane]), sb = wave_sum(lp[128 + lane] * lp[192 + lane]);
        lam = uni(__expf(sa) - __expf(sb) + lambda_init);
    }
    const float* subln = p.att_subln + (size_t)j * 128;
    bool first_ = true;
    for (;;) {
        if (tid == 0) *s_item = (first_ && ogrid() == 256) ? obid() : (int)atomicAdd(counter, 1u) + ((ogrid() == 256) ? 256 : 0);
        first_ = false;
        __syncthreads();
        const int item = *s_item;
        __syncthreads();
        if (item >= 768) break;
        if (item < 256) {
            const int r = ((item & 7) << 2) | (item >> 6), qt = 7 - ((item >> 3) & 7), b = r >> 2, h = r & 3;
            const int q0 = qt * 256;
            const size_t tokq = (size_t)(b * SEQ + q0 + w * 32 + l31);
            unsigned* O0s = (unsigned*)(lds + 53248) + tid;
#pragma unroll
            for (int sub = 0; sub < 2; ++sub) {
                bf16x8 qf[4];
#pragma unroll
                for (int ks = 0; ks < 4; ++ks) qf[ks] = *(const bf16x8*)(PROJ + tokq * ATT_IN + 1536 + (2 * h + sub) * 64 + ks * 16 + 8 * hh);
                f32x16 O[4];
#pragma unroll
                for (int dt = 0; dt < 4; ++dt)
#pragma unroll
                    for (int i = 0; i < 16; ++i) O[dt][i] = 0.f;
                float m_run = -1e29f, l_run = 0.f;
                attn_pass<128, false>(PROJ + (size_t)(b * SEQ) * ATT_IN + 2048 + (2 * h + sub) * 64, VT + (size_t)(b * 1024 + 512 + h * 128) * SEQ, qf, q0, O, m_run, l_run, lds, p.wave);
                const float lt = l_run + shx(l_run, 32);
                const float inv = 1.f / lt;
                if (sub == 0) {
#pragma unroll
                    for (int dt = 0; dt < 4; ++dt)
#pragma unroll
                        for (int i = 0; i < 8; ++i) O0s[(dt * 8 + i) * 512] = pk_bf16(O[dt][2 * i] * inv, O[dt][2 * i + 1] * inv);
                } else {
                    float ss = 0.f;
#pragma unroll
                    for (int dt = 0; dt < 4; ++dt)
#pragma unroll
                        for (int i = 0; i < 8; ++i) { const unsigned pw = O0s[(dt * 8 + i) * 512];
                            const float v0 = __uint_as_float(pw << 16) - lam * O[dt][2 * i] * inv, v1 = __uint_as_float(pw & 0xffff0000u) - lam * O[dt][2 * i + 1] * inv;
                            O[dt][2 * i] = v0; O[dt][2 * i + 1] = v1; ss += v0 * v0 + v1 * v1; }
                    ss += shx(ss, 32);
                    const float rs = rsqrtf(ss * (1.f / 128.f) + EPS) * (1.f - lambda_init);
                    bf16_t* dst = MIX + tokq * DM + 512 + h * 128;
#pragma unroll
                    for (int dt = 0; dt < 4; ++dt)
#pragma unroll
                        for (int g = 0; g < 4; ++g) { const int dv = 32 * dt + 8 * g + 4 * hh; const f32x4 gn = *(const f32x4*)(subln + dv);
                            u32x2 o; o[0] = pk_bf16(O[dt][4 * g] * rs * gn[0], O[dt][4 * g + 1] * rs * gn[1]); o[1] = pk_bf16(O[dt][4 * g + 2] * rs * gn[2], O[dt][4 * g + 3] * rs * gn[3]);
                            *(u32x2*)(dst + dv) = o; }
                }
            }
        } else {
            const int jj = item - 256;
            const int qt = 7 - (jj >> 6), r = jj & 63, b = r >> 3, h = r & 7;
            const int q0 = qt * 256;
            const size_t tokq = (size_t)(b * SEQ + q0 + w * 32 + l31);
            bf16x8 qf[4];
#pragma unroll
            for (int ks = 0; ks < 4; ++ks) qf[ks] = *(const bf16x8*)(PROJ + tokq * ATT_IN + h * 64 + ks * 16 + 8 * hh);
            f32x16 O[2];
#pragma unroll
            for (int dt = 0; dt < 2; ++dt)
#pragma unroll
                for (int i = 0; i < 16; ++i) O[dt][i] = 0.f;
            float m_run = -1e29f, l_run = 0.f;
            attn_pass<64, true>(PROJ + (size_t)(b * SEQ) * ATT_IN + 512 + h * 64, VT + (size_t)(b * 1024 + h * 64) * SEQ, qf, q0, O, m_run, l_run, lds, p.wave);
            const float lt = l_run + shx(l_run, 32);
            const float inv = 1.f / lt;
            bf16_t* dst = MIX + tokq * DM + h * 64;
#pragma unroll
            for (int dt = 0; dt < 2; ++dt)
#pragma unroll
                for (int g = 0; g < 4; ++g) { const int dv = 32 * dt + 8 * g + 4 * hh;
                    u32x2 o; o[0] = pk_bf16(O[dt][4 * g] * inv, O[dt][4 * g + 1] * inv); o[1] = pk_bf16(O[dt][4 * g + 2] * inv, O[dt][4 * g + 3] * inv);
                    *(u32x2*)(dst + dv) = o; }
        }
    }
}

template <bool FULL>
DI void hgrn_pass(const Params& p, const int j, char* lds) {
    unsigned char* ws = p.ws;
    const bf16_t* PROJ = (const bf16_t*)(ws + OFF_P);
    const bf16_t* IT = PROJ + (size_t)M_TOK * ATT_IN;
    const float* LOGF = (const float*)(ws + OFF_T);
    bf16_t* UB = (bf16_t*)(ws + OFF_U);
    float* DB = (float*)(ws + OFF_D);
    bf16_t* MIX = (bf16_t*)(ws + OFF_HB);
    const float* ggain = p.rec_gnorm + (size_t)j * 128;
    const int tid512 = otid_w(p.wave), grp = tid512 >> 8, tid = tid512 & 255, lane = tid & 63, w = tid >> 6, l31 = lane & 31, hh = lane >> 5;
    constexpr int LQ = 136, LV = 40, LO = 132;
    float* tot = (float*)(lds + grp * 57344);
    float* dvec = tot + 256;
    float* Bc = dvec + 128;
    float* Ot = Bc;
    bf16_t* Qh = (bf16_t*)(Bc + 32 * LO);
    bf16_t* Kt = Qh + 32 * LQ;
    bf16_t* KhT = Kt + 32 * LQ;
    bf16_t* VTs = KhT + 128 * LV;
    const int kk = tid & 127, half = tid >> 7;
    for (int item0 = obid() * 2; item0 < 512; item0 += ogrid() * 2) {
        const int item = item0 + grp, bh = item >> 3, seg = item & 7, b = bh >> 3, h = bh & 7;
        f32x16 S[4];
#pragma unroll
        for (int kt = 0; kt < 4; ++kt)
#pragma unroll
            for (int i = 0; i < 16; ++i) S[kt][i] = 0.f;
        if (FULL) {
            for (int i = 0; i < seg; ++i) {
                const bf16_t* U = UB + ((size_t)(bh * 8 + i) * 4 + w) * 4096 + lane * 16;
                const float* D = DB + (size_t)(bh * 8 + i) * 128;
#pragma unroll
                for (int kt = 0; kt < 4; ++kt) {
                    const u32x4 u0 = *(const u32x4*)(U + kt * 1024), u1 = *(const u32x4*)(U + kt * 1024 + 8);
#pragma unroll
                    for (int g = 0; g < 4; ++g) { const f32x4 dv = *(const f32x4*)(D + 32 * kt + 8 * g + 4 * hh);
                        const unsigned w0 = (g < 2) ? u0[2 * g] : u1[2 * (g - 2)], w1 = (g < 2) ? u0[2 * g + 1] : u1[2 * (g - 2) + 1];
                        S[kt][4 * g + 0] = S[kt][4 * g + 0] * dv[0] + __uint_as_float(w0 << 16);
                        S[kt][4 * g + 1] = S[kt][4 * g + 1] * dv[1] + __uint_as_float(w0 & 0xffff0000u);
                        S[kt][4 * g + 2] = S[kt][4 * g + 2] * dv[2] + __uint_as_float(w1 << 16);
                        S[kt][4 * g + 3] = S[kt][4 * g + 3] * dv[3] + __uint_as_float(w1 & 0xffff0000u); }
                }
            }
        }
        const size_t rowS = (size_t)b * SEQ + seg * 256;
        float segsum = 0.f;
        float lf[16]; u32x4 kq[2], qq[2], vv[2];
#define H_LOADS(c) do { const size_t r0_ = rowS + (c) * 32; \
            _Pragma("unroll") for (int t = 0; t < 16; ++t) lf[t] = LOGF[(r0_ + 16 * half + t) * DM + h * 128 + kk]; \
            _Pragma("unroll") for (int i = 0; i < 2; ++i) { const int ci = tid + 256 * i, t = ci >> 4, k8 = (ci & 15) * 8; \
                kq[i] = *(const u32x4*)(PROJ + (r0_ + t) * ATT_IN + 1024 + h * 128 + k8); if (FULL) qq[i] = *(const u32x4*)(PROJ + (r0_ + t) * ATT_IN + h * 128 + k8); } \
            _Pragma("unroll") for (int i = 0; i < 2; ++i) { const int ci = tid + 256 * i, v = ci >> 2, s8 = (ci & 3) * 8; \
                vv[i] = *(const u32x4*)(IT + (size_t)(b * 1024 + h * 128 + v) * SEQ + seg * 256 + (c) * 32 + s8); } } while (0)
        H_LOADS(0);
        for (int c = 0; c < 8; ++c) {
            const size_t row0 = rowS + c * 32;
            float bc[16];
            {
                float run = 0.f;
#pragma unroll
                for (int t = 0; t < 16; ++t) { run += lf[t]; bc[t] = run; }
                tot[half * 128 + kk] = run;
            }
            __syncthreads();
            {
                const float t0v = tot[kk], t1v = tot[128 + kk];
                const float blast = t0v + t1v;
                const float add = half ? t0v : 0.f;
                if (half == 0) { dvec[kk] = __expf(blast); segsum += blast; }
#pragma unroll
                for (int t = 0; t < 16; ++t) Bc[(16 * half + t) * LO + kk] = bc[t] + add;
            }
            __syncthreads();
#pragma unroll
            for (int i = 0; i < 2; ++i) {
                const int ci = tid + 256 * i, t = ci >> 4, k8 = (ci & 15) * 8;
                const f32x4 b0 = *(const f32x4*)(Bc + t * LO + k8), b1 = *(const f32x4*)(Bc + t * LO + k8 + 4);
                const f32x4 ta = *(const f32x4*)(tot + k8), tb = *(const f32x4*)(tot + k8 + 4), tc = *(const f32x4*)(tot + 128 + k8), td = *(const f32x4*)(tot + 128 + k8 + 4);
                float bcv[8], blv[8], kf[8], qf[8];
#pragma unroll
                for (int e = 0; e < 4; ++e) { bcv[e] = b0[e]; bcv[4 + e] = b1[e]; blv[e] = ta[e] + tc[e]; blv[4 + e] = tb[e] + td[e]; }
#pragma unroll
                for (int e = 0; e < 4; ++e) { kf[2 * e] = __uint_as_float(kq[i][e] << 16); kf[2 * e + 1] = __uint_as_float(kq[i][e] & 0xffff0000u); }
#pragma unroll
                for (int e = 0; e < 8; ++e) KhT[(k8 + (e ^ ((k8 >> 3) & 7))) * LV + t] = f2bf(kf[e] * __expf(blv[e] - bcv[e]));
                if (FULL) {
#pragma unroll
                    for (int e = 0; e < 4; ++e) { qf[2 * e] = __uint_as_float(qq[i][e] << 16); qf[2 * e + 1] = __uint_as_float(qq[i][e] & 0xffff0000u); }
                    u32x4 oq, ok;
#pragma unroll
                    for (int e = 0; e < 4; ++e) {
                        oq[e] = pk_bf16(qf[2 * e] * __expf(bcv[2 * e]), qf[2 * e + 1] * __expf(bcv[2 * e + 1]));
                        ok[e] = pk_bf16(kf[2 * e] * __expf(-bcv[2 * e]), kf[2 * e + 1] * __expf(-bcv[2 * e + 1])); }
                    *(u32x4*)(Qh + t * LQ + k8) = oq; *(u32x4*)(Kt + t * LQ + k8) = ok;
                }
            }
#pragma unroll
            for (int i = 0; i < 2; ++i) { const int ci = tid + 256 * i, v = ci >> 2, s8 = (ci & 3) * 8; *(u32x4*)(VTs + v * LV + s8) = vv[i]; }
            u32x4 gg0, gg1;
            if (FULL) { const int t = tid >> 3, sg = tid & 7; const bf16_t* gp = PROJ + (row0 + t) * ATT_IN + 2048 + h * 128 + sg * 16; gg0 = *(const u32x4*)gp; gg1 = *(const u32x4*)(gp + 8); }
            if (c + 1 < 8) H_LOADS(c + 1);
            __syncthreads();
            f32x16 o;
            if (FULL) {
                f32x16 at;
#pragma unroll
                for (int i = 0; i < 16; ++i) at[i] = 0.f;
#pragma unroll
                for (int ks = 0; ks < 8; ++ks) { const bf16x8 a = *(const bf16x8*)(Kt + l31 * LQ + ks * 16 + 8 * hh); const bf16x8 bq = *(const bf16x8*)(Qh + l31 * LQ + ks * 16 + 8 * hh); at = MFMA32(a, bq, at); }
#pragma unroll
                for (int i = 0; i < 16; ++i) at[i] = (crow(i, hh) <= l31) ? at[i] : 0.f;
#pragma unroll
                for (int i = 0; i < 16; ++i) o[i] = 0.f;
#pragma unroll
                for (int kt = 0; kt < 4; ++kt)
#pragma unroll
                    for (int s2 = 0; s2 < 2; ++s2) { const bf16_t* qp = Qh + l31 * LQ + 32 * kt + 16 * s2 + 4 * hh; const bf16x8 aq = ld_b64x2(qp, qp + 8); const bf16x8 bs = pack8(S[kt], s2); o = MFMA32(aq, bs, o); }
#pragma unroll
                for (int s2 = 0; s2 < 2; ++s2) { const bf16_t* vp = VTs + (32 * w + l31) * LV + 16 * s2 + 4 * hh; const bf16x8 bv = ld_b64x2(vp, vp + 8); const bf16x8 pa = pack8(at, s2); o = MFMA32(pa, bv, o); }
            }
#pragma unroll
            for (int kt = 0; kt < 4; ++kt) {
#pragma unroll
                for (int g = 0; g < 4; ++g) { const f32x4 dv = *(const f32x4*)(dvec + 32 * kt + 8 * g + 4 * hh);
                    S[kt][4 * g] *= dv[0]; S[kt][4 * g + 1] *= dv[1]; S[kt][4 * g + 2] *= dv[2]; S[kt][4 * g + 3] *= dv[3]; }
#pragma unroll
                for (int s2 = 0; s2 < 2; ++s2) { const int kr_ = 32 * kt + l31; const bf16x8 a = *(const bf16x8*)(KhT + (kr_ ^ ((kr_ >> 3) & 7)) * LV + 16 * s2 + 8 * hh); const bf16x8 bv = *(const bf16x8*)(VTs + (32 * w + l31) * LV + 16 * s2 + 8 * hh); S[kt] = MFMA32(a, bv, S[kt]); }
            }
            if (FULL) {
#pragma unroll
                for (int i = 0; i < 16; ++i) Ot[crow(i, hh) * LO + 32 * w + l31] = o[i];
                __syncthreads();
                const int t = tid >> 3, sg = tid & 7;
                f32x4 ov[4]; float ss = 0.f;
#pragma unroll
                for (int q = 0; q < 4; ++q) { ov[q] = *(const f32x4*)(Ot + t * LO + sg * 16 + 4 * q); ss += ov[q][0] * ov[q][0] + ov[q][1] * ov[q][1] + ov[q][2] * ov[q][2] + ov[q][3] * ov[q][3]; }
                ss += shx(ss, 1); ss += shx(ss, 2); ss += shx(ss, 4);
                const float rs = rsqrtf(ss * (1.f / 128.f) + EPS);
                float gt[16];
#pragma unroll
                for (int e = 0; e < 4; ++e) { gt[2 * e] = __uint_as_float(gg0[e] << 16); gt[2 * e + 1] = __uint_as_float(gg0[e] & 0xffff0000u);
                    gt[8 + 2 * e] = __uint_as_float(gg1[e] << 16); gt[8 + 2 * e + 1] = __uint_as_float(gg1[e] & 0xffff0000u); }
                float res[16];
#pragma unroll
                for (int q = 0; q < 4; ++q) { const f32x4 gn = *(const f32x4*)(ggain + sg * 16 + 4 * q);
#pragma unroll
                    for (int e = 0; e < 4; ++e) res[4 * q + e] = ov[q][e] * rs * gn[e] * gt[4 * q + e]; }
                u32x4 o0, o1;
#pragma unroll
                for (int e = 0; e < 4; ++e) { o0[e] = pk_bf16(res[2 * e], res[2 * e + 1]); o1[e] = pk_bf16(res[8 + 2 * e], res[8 + 2 * e + 1]); }
                bf16_t* dst = MIX + (row0 + t) * DM + h * 128 + sg * 16;
                *(u32x4*)dst = o0; *(u32x4*)(dst + 8) = o1;
            }
        }
#undef H_LOADS
        if (!FULL) {
            bf16_t* U = UB + ((size_t)item * 4 + w) * 4096 + lane * 16;
#pragma unroll
            for (int kt = 0; kt < 4; ++kt) {
                u32x4 u0, u1;
#pragma unroll
                for (int e = 0; e < 4; ++e) { u0[e] = pk_bf16(S[kt][2 * e], S[kt][2 * e + 1]); u1[e] = pk_bf16(S[kt][8 + 2 * e], S[kt][8 + 2 * e + 1]); }
                *(u32x4*)(U + kt * 1024) = u0; *(u32x4*)(U + kt * 1024 + 8) = u1;
            }
            if (half == 0) DB[(size_t)item * 128 + kk] = __expf(segsum);
        }
        __syncthreads();
    }
}

#define XB_TMO      128
#define XB_XCNT(j)  (256  + 64 * (j))
#define XB_XSUB(j)  (1280 + 64 * (j))
#define XB_XGEN(j)  (2304 + 64 * (j))
#define XB_TOP      3328
#define XB_TOPGEN   3392
#define XCD_BAR_WORDS 3456
#define XB_SPIN_CAP (1u << 18)
#define LAS __attribute__((address_space(3)))
DI unsigned xb_ld(unsigned* p)              { return __hip_atomic_load(p, __ATOMIC_RELAXED, __HIP_MEMORY_SCOPE_AGENT); }
DI unsigned xb_add(unsigned* p, unsigned v) { return __hip_atomic_fetch_add(p, v, __ATOMIC_RELAXED, __HIP_MEMORY_SCOPE_AGENT); }
DI unsigned xb_xcc_id() { return (unsigned)__builtin_amdgcn_s_getreg((3 << 11) | 20) & 0xFu; }
#define XB_SPIN(cond, bar) do { unsigned _sp = 0; while (cond) { __builtin_amdgcn_s_sleep(1); \
    if ((++_sp & 255u) == 0u) { if (xb_ld(&(bar)[XB_TMO])) break; if (_sp > XB_SPIN_CAP) { atomicAdd(&(bar)[XB_TMO], 1u); break; } } } } while (0)
struct XcdBarrier { unsigned* bar; unsigned x; volatile LAS unsigned* st; };
DI XcdBarrier xcd_barrier_post(unsigned* bar, volatile LAS unsigned* st, const int gw) {
    XcdBarrier b; b.bar = bar; b.x = xb_xcc_id(); b.st = st;
    if (gw == 0 && olane() == 0) (void)xb_add(&bar[XB_XCNT(b.x)], 1u);
    return b;
}
DI void xcd_barrier_complete(unsigned* bar, unsigned x, unsigned& nloc, unsigned& nx) {
    const unsigned G = gridDim.x * gridDim.y * gridDim.z;
    unsigned sum, cnt, mine, sp = 0u;
    for (;;) {
        sum = 0u; cnt = 0u; mine = 0u;
#pragma unroll
        for (unsigned j = 0; j < 16; ++j) { const unsigned c = xb_ld(&bar[XB_XCNT(j)]); sum += c; cnt += (c > 0u) ? 1u : 0u; mine = (j == x) ? c : mine; }
        if (sum == G) break;
        __builtin_amdgcn_s_sleep(1);
        if ((++sp & 255u) == 0u) { if (xb_ld(&bar[XB_TMO])) break; if (sp > XB_SPIN_CAP) { atomicAdd(&bar[XB_TMO], 1u); break; } }
    }
    nloc = mine > 0u ? mine : 1u; nx = cnt > 0u ? cnt : 1u;
}
DI void xcd_barrier(const XcdBarrier& b, const int gw) {
    asm volatile("s_waitcnt vmcnt(0)" ::: "memory");
    __syncthreads();
    if (gw == 0 && olane() == 0) {
        unsigned* bar = b.bar;
        __builtin_amdgcn_s_waitcnt(0);
        unsigned nloc = b.st[0], nx = b.st[1];
        if (nloc == 0u) { xcd_barrier_complete(bar, b.x, nloc, nx); b.st[0] = nloc; b.st[1] = nx; }
        const unsigned old = xb_add(&bar[XB_XSUB(b.x)], 1u);
        const unsigned gen = old / nloc;
        if (old + 1u == (gen + 1u) * nloc) {
            __builtin_amdgcn_fence(__ATOMIC_RELEASE, "agent");
            asm volatile("s_waitcnt vmcnt(0)" ::: "memory");
            const unsigned og = xb_add(&bar[XB_TOP], 1u);
            const unsigned tg = og / nx;
            if (og + 1u == (tg + 1u) * nx) xb_add(&bar[XB_TOPGEN], 1u);
            else XB_SPIN(xb_ld(&bar[XB_TOPGEN]) == tg, bar);
            __builtin_amdgcn_fence(__ATOMIC_ACQUIRE, "agent");
            xb_add(&bar[XB_XGEN(b.x)], 1u);
            asm volatile("s_waitcnt vmcnt(0)" ::: "memory");
        } else {
            XB_SPIN(xb_ld(&bar[XB_XGEN(b.x)]) == gen, bar);
            __builtin_amdgcn_fence(__ATOMIC_ACQUIRE, "agent");
            asm volatile("s_waitcnt vmcnt(0)" ::: "memory");
        }
    }
    __syncthreads();
}

#ifndef PROBE_DUP
#define PROBE_DUP 0
#endif
#if PROBE_DUP == 1
constexpr int NST = 11; constexpr unsigned long long SEQ64 = 0x65544322100ull; constexpr int NPRE = 1;
#elif PROBE_DUP == 2
constexpr int NST = 8; constexpr unsigned long long SEQ64 = 0x65432110ull; constexpr int NPRE = 1;
#elif PROBE_DUP == 8
constexpr int NST = 7; constexpr unsigned long long SEQ64 = 0x6543210ull; constexpr int NPRE = 2;
#else
constexpr int NST = 7; constexpr unsigned long long SEQ64 = 0x6543210ull; constexpr int NPRE = 1;
#endif
constexpr int NPH = NPRE + 4 * NST;
__global__ void __launch_bounds__(NTHREADS) fwd_kernel(Params p) {
    __shared__ __attribute__((aligned(16))) char lds[LDS_BYTES];
    cg::grid_group grid = cg::this_grid();
    __shared__ __attribute__((aligned(16))) unsigned xb_words[4];
    if (threadIdx.x < 4) xb_words[threadIdx.x] = 0u;
    __syncthreads();
    const int g_wave = __builtin_amdgcn_readfirstlane((int)(threadIdx.x >> 6));
    (void)xcd_barrier_post((unsigned*)(p.ws + OFF_BAR), (volatile LAS unsigned*)&xb_words, g_wave);
#define XBAR() do { XcdBarrier xb_; xb_.bar = (unsigned*)(p.ws + OFF_BAR); xb_.x = xb_xcc_id(); xb_.st = (volatile LAS unsigned*)&xb_words; xcd_barrier(xb_, g_wave); } while (0)
    for (int ph = p.ph_lo; ph < p.ph_hi; ++ph) {
        Params q = p; q.wave = g_wave;
        asm volatile("" : "+s"(q.ws), "+s"(q.out), "+s"(q.x), "+s"(q.norm_gains));
        unsigned char* ws = q.ws;
        if (ph < NPRE) {
            prep_phase(q, lds);
        } else {
            const int L = (ph - NPRE) / NST, st = (int)((SEQ64 >> (4 * ((ph - NPRE) % NST))) & 15ull), j = L >> 1;
            const float* gains = q.norm_gains + (size_t)L * 4 * DM;
            const bf16_t* HB = (const bf16_t*)(ws + OFF_HB);
            switch (st) {
            case 0:
                if ((L & 1) == 0) gemm_phase<EPI_ATT_IN>(HB, (const bf16_t*)(ws + OFF_ATT_IN_T) + (size_t)j * ATT_IN * DM, DM, ATT_IN, q, j, lds);
                else gemm_phase<EPI_REC_IN>(HB, (const bf16_t*)(ws + OFF_REC_IN_T) + (size_t)j * REC_IN * DM, DM, REC_IN, q, j, lds);
                break;
            case 1:
                if ((L & 1) == 0) attn_phase(q, j, lds, ph); else { hgrn_pass<false>(q, j, lds); XBAR(); hgrn_pass<true>(q, j, lds); }
                break;
            case 2: case 5: {
                const bf16_t* Ap = (st == 2) ? HB : (const bf16_t*)(ws + OFF_P);
                const bf16_t* Bp = (st == 2) ? (((L & 1) == 0) ? (const bf16_t*)(ws + OFF_ATT_OUT_T) + (size_t)j * DM * DM : (const bf16_t*)(ws + OFF_REC_OUT_T) + (size_t)j * DM * DM)
                                             : (const bf16_t*)(ws + OFF_FFN_OUT_T) + (size_t)L * DM * FFN_H;
                gemm_phase<EPI_F32>(Ap, Bp, (st == 2) ? DM : FFN_H, DM, q, j, lds);
                break; }
            case 3:
                row_phase((const bf16_t*)(ws + OFF_T), L == 0 ? q.x : q.out, q.out, gains + DM, gains + 2 * DM, (bf16_t*)(ws + OFF_HB), q.wave);
                break;
            case 4:
                gemm_phase<EPI_FFN_IN>(HB, (const bf16_t*)(ws + OFF_FFN_IN_T) + (size_t)L * FFN_IN * DM, DM, FFN_IN, q, j, lds);
                if (L < 3) { const int rem_ = ((M_TOK / 256) * (FFN_IN / 256)) % ogrid();
                    if (obid() >= rem_) convert_layer_weights(q, L + 1, obid() - rem_, ogrid() - rem_, lds, 2); }
                break;
            default:
                row_phase((const bf16_t*)(ws + OFF_T), q.out, q.out, gains + 3 * DM, L < 3 ? gains + 4 * DM : nullptr, L < 3 ? (bf16_t*)(ws + OFF_HB) : nullptr, q.wave);
                break;
            }
        }
        if (ph + 1 < p.ph_hi) { if (p.ph_hi < 0) grid.sync(); else XBAR(); }
    }
}

#ifndef ONE_LAUNCH
#define ONE_LAUNCH 1
#endif

extern "C" void kernel_launch(void* const* d_in, const int* in_sizes, int n_in, void* d_out, int out_size, void* d_ws, size_t ws_size, hipStream_t stream) {
    static int grid_blocks = 0;
    if (!grid_blocks) {
        int dev = 0, cus = 0, per_cu = 0;
        hipGetDevice(&dev);
        hipDeviceGetAttribute(&cus, hipDeviceAttributeMultiprocessorCount, dev);
        hipOccupancyMaxActiveBlocksPerMultiprocessor(&per_cu, fwd_kernel, NTHREADS, 0);
        if (per_cu > 1) per_cu = 1;
        grid_blocks = cus * per_cu;
        if (ws_size < WS_NEED) { fprintf(stderr, "workspace too small: %zu < %zu\n", ws_size, (size_t)WS_NEED); grid_blocks = 0; return; }
    }
    Params p{};
    p.x = (const float*)d_in[0]; p.norm_gains = (const float*)d_in[1]; p.att_w_in = (const float*)d_in[2]; p.att_lambda = (const float*)d_in[3];
    p.att_subln = (const float*)d_in[4]; p.att_w_out = (const float*)d_in[5]; p.rec_w_in = (const float*)d_in[6]; p.rec_lb = (const float*)d_in[7];
    p.rec_gnorm = (const float*)d_in[8]; p.rec_w_out = (const float*)d_in[9]; p.ffn_w_in = (const float*)d_in[10]; p.ffn_w_out = (const float*)d_in[11];
    p.out = (float*)d_out; p.ws = (unsigned char*)d_ws;
    hipMemsetAsync((char*)d_ws + OFF_BAR, 0, 16384, stream);
#if ONE_LAUNCH
    p.ph_lo = 0; p.ph_hi = NPH;
    void* args[] = {&p};
    hipError_t e = hipLaunchCooperativeKernel((void*)fwd_kernel, dim3(grid_blocks), dim3(NTHREADS), args, 0, stream);
    if (e != hipSuccess) fprintf(stderr, "cooperative launch failed: %s (grid %d)\n", hipGetErrorString(e), grid_blocks);
#else
    for (int ph = 0; ph < NPH; ++ph) {
        p.ph_lo = ph; p.ph_hi = ph + 1;
        void* args[] = {&p};
        hipLaunchCooperativeKernel((void*)fwd_kernel, dim3(grid_blocks), dim3(NTHREADS), args, 0, stream);
    }
#endif
}
```

```cpp
#include <hip/hip_runtime.h>
#include <hip/hip_cooperative_groups.h>
#include <cstdio>
#include <cstdint>
namespace cg = cooperative_groups;

typedef unsigned short bf16_t;
typedef short bf16x8 __attribute__((ext_vector_type(8)));
typedef short s16x4 __attribute__((ext_vector_type(4)));
typedef float f32x16 __attribute__((ext_vector_type(16)));
typedef float f32x4 __attribute__((ext_vector_type(4)));
typedef unsigned u32x4 __attribute__((ext_vector_type(4)));
typedef unsigned u32x2 __attribute__((ext_vector_type(2)));
typedef __bf16 bf16x2_t __attribute__((ext_vector_type(2)));
typedef float f32x2_t __attribute__((ext_vector_type(2)));

#define DI __device__ __forceinline__
#define MFMA32(a, b, c) __builtin_amdgcn_mfma_f32_32x32x16_bf16((a), (b), (c), 0, 0, 0)

constexpr int NTHREADS = 512;
constexpr int M_TOK = 16384, DM = 1024, SEQ = 2048, NB = 8;
constexpr int ATT_IN = 3072, REC_IN = 4096, FFN_H = 2816, FFN_IN = 5632;
constexpr float EPS = 1e-6f;
constexpr float LOG2E = 1.4426950408889634f;
constexpr int LDS_BYTES = 131072 + 64;

constexpr size_t OFF_CTRL = 0;
constexpr size_t OFF_ROPE = 4096;
constexpr size_t OFF_WT = OFF_ROPE + 2 * 2048 * 32 * 4;
constexpr size_t N_ATT_IN_T = (size_t)2 * ATT_IN * DM;
constexpr size_t N_ATT_OUT_T = (size_t)2 * DM * DM;
constexpr size_t N_REC_IN_T = (size_t)2 * REC_IN * DM;
constexpr size_t N_REC_OUT_T = (size_t)2 * DM * DM;
constexpr size_t N_FFN_IN_T = (size_t)4 * FFN_IN * DM;
constexpr size_t N_FFN_OUT_T = (size_t)4 * DM * FFN_H;
constexpr size_t OFF_ATT_IN_T = OFF_WT;
constexpr size_t OFF_ATT_OUT_T = OFF_ATT_IN_T + N_ATT_IN_T * 2;
constexpr size_t OFF_REC_IN_T = OFF_ATT_OUT_T + N_ATT_OUT_T * 2;
constexpr size_t OFF_REC_OUT_T = OFF_REC_IN_T + N_REC_IN_T * 2;
constexpr size_t OFF_FFN_IN_T = OFF_REC_OUT_T + N_REC_OUT_T * 2;
constexpr size_t OFF_FFN_OUT_T = OFF_FFN_IN_T + N_FFN_IN_T * 2;
constexpr size_t OFF_HB = OFF_FFN_OUT_T + N_FFN_OUT_T * 2;
constexpr size_t OFF_P = OFF_HB + (size_t)M_TOK * DM * 2;
constexpr size_t OFF_T = OFF_P + (size_t)M_TOK * 4096 * 2;
constexpr size_t OFF_U = OFF_T + (size_t)M_TOK * DM * 4;
constexpr size_t OFF_D = OFF_U + (size_t)512 * 16384 * 2;
constexpr size_t OFF_BAR = OFF_D + (size_t)512 * 128 * 4;
constexpr size_t WS_NEED = OFF_BAR + 16384;

struct Params {
    const float* x; const float* norm_gains; const float* att_w_in; const float* att_lambda; const float* att_subln;
    const float* att_w_out; const float* rec_w_in; const float* rec_lb; const float* rec_gnorm; const float* rec_w_out;
    const float* ffn_w_in; const float* ffn_w_out;
    float* out; unsigned char* ws;
    int ph_lo, ph_hi;
    int wave, pad0;
};

DI int obid() { int b = blockIdx.x; asm volatile("" : "+s"(b)); return b; }
DI int ogrid() { int g = gridDim.x; asm volatile("" : "+s"(g)); return g; }
DI int olane() { int l; asm volatile("v_mbcnt_lo_u32_b32 %0, -1, 0\n\tv_mbcnt_hi_u32_b32 %0, -1, %0" : "=v"(l)); return l; }
DI int otid_w(int gw) { return (gw << 6) | olane(); }
DI unsigned pk_bf16(float a, float b) { f32x2_t v = {a, b}; bf16x2_t r = __builtin_convertvector(v, bf16x2_t); return __builtin_bit_cast(unsigned, r); }
DI float bf2f(bf16_t u) { return __uint_as_float(((unsigned)u) << 16); }
DI bf16_t f2bf(float a) { return (bf16_t)(pk_bf16(a, 0.f) & 0xffffu); }
DI int crow(int i, int h) { return (i & 3) + 8 * (i >> 2) + 4 * h; }
DI float shx(float v, int mask) { const int l = olane(); return __builtin_bit_cast(float, __builtin_amdgcn_ds_bpermute(((l ^ mask) & 63) << 2, __builtin_bit_cast(int, v))); }
DI float oconst(float c) { asm volatile("" : "+v"(c)); return c; }
DI float uni(float x) { return __builtin_bit_cast(float, __builtin_amdgcn_readfirstlane(__builtin_bit_cast(int, x))); }
DI float wave_sum(float v) {
#pragma unroll
    for (int o = 32; o >= 1; o >>= 1) v += shx(v, o);
    return v;
}
DI float silu_f(float x) { return x * __builtin_amdgcn_rcpf(1.f + __expf(-x)); }
DI bf16x8 pack8(const f32x16& x, int s) {
    u32x4 p;
    p[0] = pk_bf16(x[8 * s + 0], x[8 * s + 1]); p[1] = pk_bf16(x[8 * s + 2], x[8 * s + 3]);
    p[2] = pk_bf16(x[8 * s + 4], x[8 * s + 5]); p[3] = pk_bf16(x[8 * s + 6], x[8 * s + 7]);
    return __builtin_bit_cast(bf16x8, p);
}
DI bf16x8 ld_b64x2(const bf16_t* p0, const bf16_t* p1) {
    u32x2 a = *(const u32x2*)p0, b = *(const u32x2*)p1;
    u32x4 r; r[0] = a[0]; r[1] = a[1]; r[2] = b[0]; r[3] = b[1];
    return __builtin_bit_cast(bf16x8, r);
}

DI void transpose_tiles(const float* src, bf16_t* dst, int K, int N, bool perm, int& tile_base, char* lds, const int gw, const int vbid, const int vgrid) {
    const int tid512 = otid_w(gw), half = tid512 >> 8, tid = tid512 & 255;
    float* tl = (float*)lds + half * (64 * 65);
    const int tk = K / 64, tn = N / 64, nt = tk * tn;
    const int vb = vbid * 2 + half, nvb = vgrid * 2;
    int first = (vb - tile_base) % nvb; if (first < 0) first += nvb;
    const int iters = (nt + nvb - 1) / nvb;
    f32x4 rv[4];
#define TT_LOAD(T) do { if ((T) < nt) { const int kb_ = ((T) % tk) * 64, nb_ = ((T) / tk) * 64; \
        _Pragma("unroll") for (int i = 0; i < 4; ++i) { const int kl = (tid >> 4) + 16 * i, np = nb_ + (tid & 15) * 4; \
            const int rho_ = np & 31, lo5_ = perm ? (8 * ((rho_ & 15) >> 2) + 4 * (rho_ >> 4) + (rho_ & 3)) : rho_;     \
            const int nq = (np & ~255) | (((np >> 5) & 3) << 6) | (((np >> 7) & 1) << 5) | lo5_;     \
            const int sc = perm ? (((nq >> 5) & 1) * FFN_H + (nq >> 6) * 32 + (nq & 31)) : nq; \
            rv[i] = *(const f32x4*)(src + (size_t)(kb_ + kl) * N + sc); } } } while (0)
    TT_LOAD(first);
    for (int it = 0; it < iters; ++it) {
        const int t = first + it * nvb; const bool act = t < nt;
        const int kb = (t % tk) * 64, nb = (t / tk) * 64;
        __syncthreads();
        if (act) {
#pragma unroll
            for (int i = 0; i < 4; ++i) { const int kl = (tid >> 4) + 16 * i, n4 = (tid & 15) * 4;
                tl[kl * 65 + n4 + 0] = rv[i][0]; tl[kl * 65 + n4 + 1] = rv[i][1]; tl[kl * 65 + n4 + 2] = rv[i][2]; tl[kl * 65 + n4 + 3] = rv[i][3]; }
        }
        __syncthreads();
        TT_LOAD(t + nvb);
        if (act) {
            const int nl = tid >> 2, ks = (tid & 3) * 16;
            u32x4 o0, o1;
#pragma unroll
            for (int j = 0; j < 4; ++j) {
                o0[j] = pk_bf16(tl[(ks + 2 * j) * 65 + nl], tl[(ks + 2 * j + 1) * 65 + nl]);
                o1[j] = pk_bf16(tl[(ks + 8 + 2 * j) * 65 + nl], tl[(ks + 8 + 2 * j + 1) * 65 + nl]);
            }
            bf16_t* d = dst + (size_t)(nb + nl) * K + kb + ks;
            *(u32x4*)d = o0; *(u32x4*)(d + 8) = o1;
        }
    }
#undef TT_LOAD
    tile_base = (tile_base + nt) % nvb;
}

DI void row_phase(const bf16_t* msrc, const float* xsrc, float* xdst, const float* g_post, const float* g_next, bf16_t* hdst, const int gw) {
    constexpr int RB = 4;
    const int tid = otid_w(gw); const int lane = tid & 63, w = tid >> 6;
    const int wg = obid() * 8 + w, nw = ogrid() * 8;
    for (int rowb = wg * RB; rowb < M_TOK; rowb += nw * RB) {
        f32x4 xv[RB][4], mv[RB][4];
#pragma unroll
        for (int r = 0; r < RB; ++r)
#pragma unroll
            for (int j = 0; j < 4; ++j) xv[r][j] = *(const f32x4*)(xsrc + (size_t)(rowb + r) * DM + lane * 4 + 256 * j);
        if (msrc) {
#pragma unroll
            for (int r = 0; r < RB; ++r)
#pragma unroll
                for (int j = 0; j < 4; ++j) { const u32x2 mw = *(const u32x2*)(msrc + (size_t)(rowb + r) * DM + lane * 4 + 256 * j);
                    mv[r][j] = (f32x4){__uint_as_float(mw[0] << 16), __uint_as_float(mw[0] & 0xffff0000u), __uint_as_float(mw[1] << 16), __uint_as_float(mw[1] & 0xffff0000u)}; }
            float ss[RB];
#pragma unroll
            for (int r = 0; r < RB; ++r) { ss[r] = 0.f;
#pragma unroll
                for (int j = 0; j < 4; ++j) ss[r] += mv[r][j][0] * mv[r][j][0] + mv[r][j][1] * mv[r][j][1] + mv[r][j][2] * mv[r][j][2] + mv[r][j][3] * mv[r][j][3]; }
#pragma unroll
            for (int o = 32; o >= 1; o >>= 1)
#pragma unroll
                for (int r = 0; r < RB; ++r) ss[r] += shx(ss[r], o);
#pragma unroll
            for (int j = 0; j < 4; ++j) { const f32x4 g = *(const f32x4*)(g_post + lane * 4 + 256 * j);
#pragma unroll
                for (int r = 0; r < RB; ++r) { const float r1 = rsqrtf(ss[r] * (1.f / DM) + EPS); xv[r][j] = xv[r][j] + mv[r][j] * r1 * g; *(f32x4*)(xdst + (size_t)(rowb + r) * DM + lane * 4 + 256 * j) = xv[r][j]; } }
        }
        if (hdst) {
            float ss[RB];
#pragma unroll
            for (int r = 0; r < RB; ++r) { ss[r] = 0.f;
#pragma unroll
                for (int j = 0; j < 4; ++j) ss[r] += xv[r][j][0] * xv[r][j][0] + xv[r][j][1] * xv[r][j][1] + xv[r][j][2] * xv[r][j][2] + xv[r][j][3] * xv[r][j][3]; }
#pragma unroll
            for (int o = 32; o >= 1; o >>= 1)
#pragma unroll
                for (int r = 0; r < RB; ++r) ss[r] += shx(ss[r], o);
#pragma unroll
            for (int j = 0; j < 4; ++j) { const f32x4 g = *(const f32x4*)(g_next + lane * 4 + 256 * j);
#pragma unroll
                for (int r = 0; r < RB; ++r) { const float r2 = rsqrtf(ss[r] * (1.f / DM) + EPS); const f32x4 hv = xv[r][j] * r2 * g;
                    u32x2 o; o[0] = pk_bf16(hv[0], hv[1]); o[1] = pk_bf16(hv[2], hv[3]); *(u32x2*)(hdst + (size_t)(rowb + r) * DM + lane * 4 + 256 * j) = o; } }
        }
    }
}

DI void convert_layer_weights(const Params& p, const int L, const int vbid, const int vgrid, char* lds, const int which  ) {
    unsigned char* ws = p.ws;
    const int j = L >> 1;
    int tb = 0;
    if ((which & 1) == 0) {
    } else if ((L & 1) == 0) {
        transpose_tiles(p.att_w_in + (size_t)j * DM * ATT_IN, (bf16_t*)(ws + OFF_ATT_IN_T) + (size_t)j * ATT_IN * DM, DM, ATT_IN, false, tb, lds, p.wave, vbid, vgrid);
        transpose_tiles(p.att_w_out + (size_t)j * DM * DM, (bf16_t*)(ws + OFF_ATT_OUT_T) + (size_t)j * DM * DM, DM, DM, false, tb, lds, p.wave, vbid, vgrid);
    } else {
        transpose_tiles(p.rec_w_in + (size_t)j * DM * REC_IN, (bf16_t*)(ws + OFF_REC_IN_T) + (size_t)j * REC_IN * DM, DM, REC_IN, false, tb, lds, p.wave, vbid, vgrid);
        transpose_tiles(p.rec_w_out + (size_t)j * DM * DM, (bf16_t*)(ws + OFF_REC_OUT_T) + (size_t)j * DM * DM, DM, DM, false, tb, lds, p.wave, vbid, vgrid);
    }
    if (which & 2) {
    transpose_tiles(p.ffn_w_in + (size_t)L * DM * FFN_IN, (bf16_t*)(ws + OFF_FFN_IN_T) + (size_t)L * FFN_IN * DM, DM, FFN_IN, true, tb, lds, p.wave, vbid, vgrid);
    transpose_tiles(p.ffn_w_out + (size_t)L * FFN_H * DM, (bf16_t*)(ws + OFF_FFN_OUT_T) + (size_t)L * DM * FFN_H, FFN_H, DM, false, tb, lds, p.wave, vbid, vgrid);
    }
}

DI void prep_phase(const Params& p, char* lds) {
    unsigned char* ws = p.ws;
    const int ptid = otid_w(p.wave);
    if (obid() == 0 && ptid < 64) ((unsigned*)(ws + OFF_CTRL))[ptid] = 0u;
    {
        float* cosT = (float*)(ws + OFF_ROPE); float* sinT = cosT + 2048 * 32;
        for (int idx = obid() * NTHREADS + ptid; idx < 2048 * 32; idx += ogrid() * NTHREADS) {
            const int pos = idx >> 5, i = idx & 31;
            const float inv_freq = __builtin_amdgcn_exp2f(-(float)i * (13.287712379549449f / 32.f));
            const float ang = (float)pos * inv_freq;
            const float n = rintf(ang * 0.15915494309189535f);
            float r = fmaf(-n, 6.28125f, ang); r = fmaf(-n, 1.9353071795864769e-3f, r);
            const float rev = r * 0.15915494309189535f;
            cosT[idx] = __builtin_amdgcn_cosf(rev); sinT[idx] = __builtin_amdgcn_sinf(rev);
        }
    }
    convert_layer_weights(p, 0, obid(), ogrid(), lds, 3);
    for (int L = 1; L < 4; ++L) convert_layer_weights(p, L, obid(), ogrid(), lds, 1);
    row_phase(nullptr, p.x, nullptr, nullptr, p.norm_gains, (bf16_t*)(ws + OFF_HB), p.wave);
}

enum { EPI_F32 = 0, EPI_ATT_IN = 1, EPI_REC_IN = 2, EPI_FFN_IN = 3 };
constexpr int LDK = 72;

DI int lds_byte(int r, int c) { const int st = (r >> 4) * 2 + (c >> 5), ob = (r & 15) * 64 + (c & 31) * 2; return st * 1024 + (ob ^ (((ob >> 9) & 1) << 5)); }
DI void stage_rc(int b, int& R, int& C) { const int st = b >> 10, sb = b & 1023, swz = sb ^ (((sb >> 9) & 1) << 5); R = (st / 2) * 16 + swz / 64; C = (st % 2) * 32 + (swz % 64) / 2; }

#define LAS3 __attribute__((address_space(3)))
template <int EPI>
DI void gemm_phase(const bf16_t* __restrict__ A, const bf16_t* __restrict__ Bt, const int K, const int N, const Params& p, const int layer_j, char* lds) {
    const int wid = p.wave;
    const int lane = olane(), wr = wid >> 2, wc = wid & 3;
    constexpr int HTB = 128 * 64 * 2, NXCD = 8, WGM = 1, HALF = 128;
    const int nM = M_TOK / 256, nN = N / 256, nwg = nM * nN, nt = K / 64;
    unsigned char* ws = p.ws;
    LAS3 char* L = (LAS3 char*)lds;
    int stoff = (wid * 64 + lane) * 16;
    int aoff = lds_byte(wr * 64 + (lane & 15), (lane >> 4) * 8), boff = lds_byte(wc * 32 + (lane & 15), (lane >> 4) * 8);
    asm volatile("" : "+v"(stoff), "+v"(aoff), "+v"(boff));
#define SA(b, h) (((b) * 2 + (h)) * HTB)
#define SB(b, h) ((4 + (b) * 2 + (h)) * HTB)
#define STAGE(bufoff, GB) do { const char* g_ = (GB); \
        _Pragma("unroll") for (int i_ = 0; i_ < 2; ++i_) __builtin_amdgcn_global_load_lds((const unsigned*)(g_ + voff[i_]), (LAS3 unsigned*)(L + (bufoff) + stoff + i_ * 8192), 16, 0, 0); } while (0)
#define LDA(dst, b, h) do { _Pragma("unroll") for (int m = 0; m < 4; ++m) _Pragma("unroll") for (int k = 0; k < 2; ++k) dst[m][k] = *(const LAS3 bf16x8*)(L + SA(b, h) + aoff + m * 2048 + k * 1024); } while (0)
#define LDB(dst, b, h) do { _Pragma("unroll") for (int n = 0; n < 2; ++n) _Pragma("unroll") for (int k = 0; k < 2; ++k) dst[n][k] = *(const LAS3 bf16x8*)(L + SB(b, h) + boff + n * 2048 + k * 1024); } while (0)
#define MMA(ai, bj, At_, Bt_) do { __builtin_amdgcn_s_setprio(1); _Pragma("unroll") for (int m = 0; m < 4; ++m) _Pragma("unroll") for (int n = 0; n < 2; ++n) _Pragma("unroll") for (int k = 0; k < 2; ++k) \
        acc[ai][bj][m][n] = (EPI == EPI_FFN_IN) ? __builtin_amdgcn_mfma_f32_16x16x32_bf16(Bt_[n][k], At_[m][k], acc[ai][bj][m][n], 0, 0, 0) \
                                                : __builtin_amdgcn_mfma_f32_16x16x32_bf16(At_[m][k], Bt_[n][k], acc[ai][bj][m][n], 0, 0, 0); __builtin_amdgcn_s_setprio(0); } while (0)
#define WAIT_V(n) asm volatile("s_waitcnt vmcnt(" #n ")" ::: "memory")
#define WAIT_L(n) asm volatile("s_waitcnt lgkmcnt(" #n ")" ::: "memory")
#define BAR __builtin_amdgcn_s_barrier()
#define SCHED __builtin_amdgcn_sched_barrier(0)
#define TILE_COORDS(LID, PM, PN) do { int wgid_ = (LID); \
        { const int q_ = nwg / NXCD, r_ = nwg % NXCD, xcd_ = wgid_ % NXCD, off_ = wgid_ / NXCD; wgid_ = (xcd_ < r_ ? xcd_ * (q_ + 1) : r_ * (q_ + 1) + (xcd_ - r_) * q_) + off_; } \
        const int nig_ = WGM * nN, gid_ = wgid_ / nig_, fm_ = gid_ * WGM, gsz_ = (nM - fm_) < WGM ? (nM - fm_) : WGM; \
        PM = fm_ + ((wgid_ % nig_) % gsz_); PN = (wgid_ % nig_) / gsz_; } while (0)
#define VOFF_INIT() do { _Pragma("unroll") for (int i = 0; i < 2; ++i) { int R, C; stage_rc((wid * 64 + olane()) * 16 + i * 8192, R, C); voff[i] = (unsigned)(R * K + C) * 2u; } } while (0)
    if (obid() >= nwg) return;
    int pm, pn;
    TILE_COORDS(obid(), pm, pn);
    const size_t kstep = 128, hstep = (size_t)HALF * K * 2, tstep = 2 * hstep;
    const char* cA = (const char*)A + (size_t)pm * tstep; const char* cB = (const char*)Bt + (size_t)pn * tstep;
    f32x4 acc[2][2][4][2];
#pragma unroll
    for (int a = 0; a < 2; ++a)
#pragma unroll
        for (int b = 0; b < 2; ++b)
#pragma unroll
            for (int m = 0; m < 4; ++m)
#pragma unroll
                for (int n = 0; n < 2; ++n) acc[a][b][m][n] = (f32x4){0.f, 0.f, 0.f, 0.f};
    bf16x8 At[4][2], B0[2][2], B1[2][2];
    {
        unsigned voff[2]; VOFF_INIT();
        asm volatile("s_waitcnt vmcnt(0) lgkmcnt(0)" ::: "memory");
        __syncthreads();
        STAGE(SB(0, 0), cB); STAGE(SB(0, 1), cB + hstep); STAGE(SA(0, 0), cA); STAGE(SA(0, 1), cA + hstep);
        if (wr == 1) BAR;
        WAIT_V(2); BAR;
        STAGE(SB(1, 0), cB + kstep); STAGE(SA(1, 0), cA + kstep); STAGE(SB(1, 1), cB + hstep + kstep);
        WAIT_V(6); BAR;
    }
    for (int ui = 0;; ++ui) {
        const int Lnext = (ui + 1) * ogrid() + obid();
        const bool has_next = Lnext < nwg;
        int pm2 = pm, pn2 = pn;
        if (has_next) TILE_COORDS(Lnext, pm2, pn2);
        const char* nA = (const char*)A + (size_t)pm2 * tstep; const char* nB = (const char*)Bt + (size_t)pn2 * tstep;
        unsigned voff[2]; VOFF_INIT();
        for (int t = 0; t < nt; t += 2) {
            const bool last = (t == nt - 2);
            const char* a1 = cA + (size_t)(t + 1) * kstep;
            const char* a2 = last ? nA : cA + (size_t)(t + 2) * kstep; const char* b2 = last ? nB : cB + (size_t)(t + 2) * kstep;
            const char* a3 = a2 + kstep; const char* b3 = b2 + kstep;
            LDB(B0, 0, 0); LDB(B1, 0, 1); SCHED; LDA(At, 0, 0); STAGE(SA(1, 1), a1 + hstep);
            WAIT_V(8); WAIT_L(0); BAR; MMA(0, 0, At, B0); MMA(0, 1, At, B1); BAR; SCHED;
            LDA(At, 0, 1); STAGE(SB(0, 0), b2); STAGE(SB(0, 1), b2 + hstep); STAGE(SA(0, 0), a2);
            WAIT_V(8); WAIT_L(0); BAR; MMA(1, 0, At, B0); MMA(1, 1, At, B1); BAR; SCHED;
            LDB(B0, 1, 0); LDB(B1, 1, 1); SCHED; LDA(At, 1, 0); STAGE(SA(0, 1), a2 + hstep);
            WAIT_V(8); WAIT_L(0); BAR; MMA(0, 0, At, B0); MMA(0, 1, At, B1); BAR; SCHED;
            LDA(At, 1, 1); STAGE(SB(1, 0), b3); STAGE(SB(1, 1), b3 + hstep); STAGE(SA(1, 0), a3);
            WAIT_V(8); WAIT_L(0); BAR; MMA(1, 0, At, B0); MMA(1, 1, At, B1); BAR; SCHED;
        }
        if (wr == 0) BAR;
        const int le = olane(), fr = le & 15, fq = le >> 4;
        const int row0 = pm * 256 + wr * 64 + fq * 4;
        const int col0 = pn * 256 + wc * 64;
        if (EPI == EPI_F32) {
            bf16_t* T = (bf16_t*)(ws + OFF_T) + (size_t)row0 * DM + col0 + fr;
#pragma unroll
            for (int ai = 0; ai < 2; ++ai)
#pragma unroll
                for (int m = 0; m < 4; ++m)
#pragma unroll
                    for (int j = 0; j < 4; ++j)
#pragma unroll
                        for (int bj = 0; bj < 2; ++bj)
#pragma unroll
                            for (int n = 0; n < 2; ++n) T[(size_t)(ai * 128 + m * 16 + j) * DM + bj * 32 + n * 16] = f2bf(acc[ai][bj][m][n][j]);
        } else if (EPI == EPI_FFN_IN) {
            bf16_t* HID = (bf16_t*)(ws + OFF_P) + (size_t)(pm * 256 + wr * 64 + fr) * FFN_H + (col0 >> 1) + 8 * fq;
#pragma unroll
            for (int ai = 0; ai < 2; ++ai)
#pragma unroll
                for (int m = 0; m < 4; ++m) {
                    u32x4 o;
#pragma unroll
                    for (int n = 0; n < 2; ++n) {
                        o[2 * n] = pk_bf16(silu_f(acc[ai][0][m][n][0]) * acc[ai][1][m][n][0], silu_f(acc[ai][0][m][n][1]) * acc[ai][1][m][n][1]);
                        o[2 * n + 1] = pk_bf16(silu_f(acc[ai][0][m][n][2]) * acc[ai][1][m][n][2], silu_f(acc[ai][0][m][n][3]) * acc[ai][1][m][n][3]); }
                    *(u32x4*)(HID + (size_t)(ai * 128 + m * 16) * FFN_H) = o;
                }
        } else if (EPI == EPI_ATT_IN) {
            bf16_t* PROJ = (bf16_t*)(ws + OFF_P);
            bf16_t* VT = PROJ + (size_t)M_TOK * ATT_IN;
            const int region = col0 >> 9;
            if (region == 2 || region == 5) {
                const int vc0 = (region == 2 ? col0 - 1024 : 512 + col0 - 2560);
                const int b = row0 >> 11, t0 = row0 & 2047;
                bf16_t* dst = VT + ((size_t)(b * 1024 + vc0 + fr)) * SEQ + t0;
#pragma unroll
                for (int bj = 0; bj < 2; ++bj)
#pragma unroll
                    for (int n = 0; n < 2; ++n)
#pragma unroll
                        for (int ai = 0; ai < 2; ++ai)
#pragma unroll
                            for (int m = 0; m < 4; ++m) { u32x2 o; o[0] = pk_bf16(acc[ai][bj][m][n][0], acc[ai][bj][m][n][1]); o[1] = pk_bf16(acc[ai][bj][m][n][2], acc[ai][bj][m][n][3]);
                                *(u32x2*)(dst + (size_t)(bj * 32 + n * 16) * SEQ + ai * 128 + m * 16) = o; }
            } else {
                const float sc = (region == 0 || region == 3) ? 0.125f * LOG2E : 1.0f;
                const float* cb = (const float*)(ws + OFF_ROPE) + (row0 & 2047) * 32 + fr;
                bf16_t* dst = PROJ + (size_t)row0 * ATT_IN + col0 + fr;
#pragma unroll
                for (int ai = 0; ai < 2; ++ai)
#pragma unroll
                    for (int m = 0; m < 4; ++m)
#pragma unroll
                        for (int j = 0; j < 4; ++j)
#pragma unroll
                            for (int n = 0; n < 2; ++n) {
                                const int ro = ai * 128 + m * 16 + j;
                                const float c = cb[ro * 32 + n * 16], sn = cb[2048 * 32 + ro * 32 + n * 16];
                                const float x1 = acc[ai][0][m][n][j], x2 = acc[ai][1][m][n][j];
                                dst[(size_t)ro * ATT_IN + n * 16] = f2bf((x1 * c - x2 * sn) * sc); dst[(size_t)ro * ATT_IN + 32 + n * 16] = f2bf((x2 * c + x1 * sn) * sc);
                                if (n == 1 && (j & 1)) __builtin_amdgcn_sched_barrier(0); }
            }
        } else if (EPI == EPI_REC_IN) {
            bf16_t* PROJ = (bf16_t*)(ws + OFF_P);
            bf16_t* IT = PROJ + (size_t)M_TOK * ATT_IN;
            const int region = col0 >> 10;
            if (region == 2) {
                const int vc0 = col0 - 2048;
                const int b = row0 >> 11, t0 = row0 & 2047;
                bf16_t* dst = IT + ((size_t)(b * 1024 + vc0 + fr)) * SEQ + t0;
#pragma unroll
                for (int bj = 0; bj < 2; ++bj)
#pragma unroll
                    for (int n = 0; n < 2; ++n)
#pragma unroll
                        for (int ai = 0; ai < 2; ++ai)
#pragma unroll
                            for (int m = 0; m < 4; ++m) { u32x2 o; o[0] = pk_bf16(acc[ai][bj][m][n][0], acc[ai][bj][m][n][1]); o[1] = pk_bf16(acc[ai][bj][m][n][2], acc[ai][bj][m][n][3]);
                                *(u32x2*)(dst + (size_t)(bj * 32 + n * 16) * SEQ + ai * 128 + m * 16) = o; }
            } else if (region == 1) {
                float* lf = (float*)(ws + OFF_T) + (size_t)row0 * DM + (col0 - 1024) + fr;
                bf16_t* dst = PROJ + (size_t)row0 * ATT_IN + col0 + fr;
#pragma unroll
                for (int bj = 0; bj < 2; ++bj)
#pragma unroll
                    for (int n = 0; n < 2; ++n) {
                        float lb = 0.f;
                        if (layer_j == 1) { const float a0 = p.rec_lb[col0 - 1024 + bj * 32 + n * 16 + fr], a1 = p.rec_lb[DM + col0 - 1024 + bj * 32 + n * 16 + fr]; lb = 1.f / (1.f + __expf(a0 - a1)); }
#pragma unroll
                        for (int ai = 0; ai < 2; ++ai)
#pragma unroll
                            for (int m = 0; m < 4; ++m)
#pragma unroll
                                for (int j = 0; j < 4; ++j) {
                                    const float sg = __builtin_amdgcn_rcpf(1.f + __expf(-acc[ai][bj][m][n][j])); const float fg = lb + (1.f - lb) * sg;
                                    lf[(size_t)(ai * 128 + m * 16 + j) * DM + bj * 32 + n * 16] = __logf(fg);
                                    dst[(size_t)(ai * 128 + m * 16 + j) * ATT_IN + bj * 32 + n * 16] = f2bf(1.f - fg);
                                    if (j == 3) __builtin_amdgcn_sched_barrier(0); } }
            } else {
                const int dc0 = (region == 0) ? col0 : (col0 - 3072 + 2048);
                const float sc = (region == 0) ? 0.08838834764831845f : 1.0f;
                bf16_t* dst = PROJ + (size_t)row0 * ATT_IN + dc0 + fr;
#pragma unroll
                for (int ai = 0; ai < 2; ++ai)
#pragma unroll
                    for (int m = 0; m < 4; ++m)
#pragma unroll
                        for (int j = 0; j < 4; ++j)
#pragma unroll
                            for (int bj = 0; bj < 2; ++bj)
#pragma unroll
                                for (int n = 0; n < 2; ++n) dst[(size_t)(ai * 128 + m * 16 + j) * ATT_IN + bj * 32 + n * 16] = f2bf(silu_f(acc[ai][bj][m][n][j]) * sc);
            }
        }
        if (!has_next) break;
#pragma unroll
        for (int a = 0; a < 2; ++a)
#pragma unroll
            for (int b = 0; b < 2; ++b)
#pragma unroll
                for (int m = 0; m < 4; ++m)
#pragma unroll
                    for (int n = 0; n < 2; ++n) acc[a][b][m][n] = (f32x4){0.f, 0.f, 0.f, 0.f};
        pm = pm2; pn = pn2; cA = nA; cB = nB;
        if (wr == 1) BAR;
    }
    WAIT_V(0);
    BAR;
#undef TILE_COORDS
#undef VOFF_INIT
#undef SA
#undef SB
#undef STAGE
#undef LDA
#undef LDB
#undef MMA
}

template <int DV, bool MULT>
DI void attn_pass(const bf16_t* __restrict__ Kg, const bf16_t* __restrict__ VTg, const bf16x8 (&qf)[4], const int q0, f32x16 (&O)[DV / 32], float& m_run, float& l_run, char* lds, const int gw) {
    const int tid = otid_w(gw), lane = tid & 63, w = tid >> 6, l31 = lane & 31, hh = lane >> 5;
    constexpr int LDV = 132;
    bf16_t* Ks = (bf16_t*)lds;
    bf16_t* Vs = Ks + 128 * LDK;
    constexpr int NV = DV / 32;
    const int nkt = (q0 + 256) / 128;
    const int qpos = q0 + w * 32 + l31;
    const int qhi = q0 + w * 32 + 31, q0w = q0 + w * 32;
    float adjF[16], adjM[16];
    if (MULT) {
#pragma unroll
        for (int i = 0; i < 16; ++i) { const int d = (l31 - crow(i, hh)) & 15; adjF[i] = (d == 0) ? 0.f : -1e30f; adjM[i] = ((d & 3) == 0) ? ((d == 0) ? 1.f : 0.f) : -1e30f; }
    }
    u32x4 rk[2], rv[NV];
#pragma unroll
    for (int i = 0; i < 2; ++i) { const int c = tid + 512 * i, key = c >> 3, d8 = c & 7; rk[i] = *(const u32x4*)(Kg + (size_t)key * ATT_IN + d8 * 8); }
#pragma unroll
    for (int i = 0; i < NV; ++i) { const int c = tid + 512 * i, dv = c >> 4, k8 = c & 15; rv[i] = *(const u32x4*)(VTg + (size_t)dv * SEQ + k8 * 8); }
    for (int kt = 0; kt < nkt; ++kt) {
        const int kb0 = kt * 128;
        __syncthreads();
#pragma unroll
        for (int i = 0; i < 2; ++i) { const int c = tid + 512 * i, key = c >> 3, d8 = c & 7; *(u32x4*)(Ks + key * LDK + d8 * 8) = rk[i]; }
#pragma unroll
        for (int i = 0; i < NV; ++i) { const int c = tid + 512 * i, dv = c >> 4, k8 = c & 15; u32x2 lo_, hi_; lo_[0] = rv[i][0]; lo_[1] = rv[i][1]; hi_[0] = rv[i][2]; hi_[1] = rv[i][3];
            *(u32x2*)(Vs + dv * LDV + k8 * 8) = lo_; *(u32x2*)(Vs + dv * LDV + k8 * 8 + 4) = hi_; }
        __syncthreads();
        if (kt + 1 < nkt) {
#pragma unroll
            for (int i = 0; i < 2; ++i) { const int c = tid + 512 * i, key = c >> 3, d8 = c & 7; rk[i] = *(const u32x4*)(Kg + (size_t)(kb0 + 128 + key) * ATT_IN + d8 * 8); }
#pragma unroll
            for (int i = 0; i < NV; ++i) { const int c = tid + 512 * i, dv = c >> 4, k8 = c & 15; rv[i] = *(const u32x4*)(VTg + (size_t)dv * SEQ + kb0 + 128 + k8 * 8); }
        }
#pragma unroll 1
        for (int hf = 0; hf < 2; ++hf) {
        const int kb = kb0 + hf * 64;
        const bf16_t* Kh = Ks + hf * 64 * LDK;
        const bf16_t* Vh = Vs + hf * 64;
        if (kb <= qhi) {
            f32x16 st[2];
#pragma unroll
            for (int k2 = 0; k2 < 2; ++k2) {
#pragma unroll
                for (int i = 0; i < 16; ++i) st[k2][i] = 0.f;
#pragma unroll
                for (int ks = 0; ks < 4; ++ks) { const bf16x8 a = *(const bf16x8*)(Kh + (32 * k2 + l31) * LDK + ks * 16 + 8 * hh); st[k2] = MFMA32(a, qf[ks], st[k2]); }
            }
            float mx = -1e30f;
            const bool zfar = MULT && (kb + 63 + 512 < q0w);
            const bool zmid = MULT && !zfar && (q0w - (kb + 63) > 128) && (q0w + 31 - kb <= 512);
            const bool zfree = !MULT && (kb + 63 <= q0w);
            if (zfar) {
#pragma unroll
                for (int k2 = 0; k2 < 2; ++k2)
#pragma unroll
                    for (int i = 0; i < 16; ++i) { const float sv = st[k2][i] + adjF[i]; st[k2][i] = sv; mx = fmaxf(mx, sv); }
            } else if (zmid) {
#pragma unroll
                for (int k2 = 0; k2 < 2; ++k2)
#pragma unroll
                    for (int i = 0; i < 16; ++i) { const float sv = st[k2][i] + adjM[i]; st[k2][i] = sv; mx = fmaxf(mx, sv); }
            } else if (zfree) {
#pragma unroll
                for (int k2 = 0; k2 < 2; ++k2)
#pragma unroll
                    for (int i = 0; i < 16; ++i) mx = fmaxf(mx, st[k2][i]);
            } else {
#pragma unroll
                for (int k2 = 0; k2 < 2; ++k2)
#pragma unroll
                    for (int i = 0; i < 16; ++i) {
                        const int key = kb + 32 * k2 + crow(i, hh); const int dl = qpos - key;
                        float sv;
                        if (MULT) {
                            const int c = (dl >= 0) ? ((dl <= 128 ? 1 : 0) + (((dl & 3) == 0 && dl <= 512) ? 1 : 0) + (((dl & 15) == 0) ? 1 : 0)) : 0;
                            const float adj = (c == 3) ? 1.5849625007211562f : ((c == 2) ? 1.0f : 0.0f);
                            sv = (c > 0) ? st[k2][i] + adj : -1e30f;
                        } else {
                            sv = (dl >= 0) ? st[k2][i] : -1e30f;
                        }
                        st[k2][i] = sv; mx = fmaxf(mx, sv);
                    }
            }
            mx = fmaxf(mx, shx(mx, 32));
            const float m_new = fmaxf(m_run, mx);
            if (__builtin_amdgcn_ballot_w64(m_new > m_run + 8.0f) != 0ull) {
                const float alpha = __builtin_amdgcn_exp2f(m_run - m_new);
                m_run = m_new; l_run *= alpha;
#pragma unroll
                for (int dt = 0; dt < DV / 32; ++dt)
#pragma unroll
                    for (int i = 0; i < 16; ++i) O[dt][i] *= alpha;
            }
            float ps = 0.f;
#pragma unroll
            for (int k2 = 0; k2 < 2; ++k2)
#pragma unroll
                for (int i = 0; i < 16; ++i) { const float pe = __builtin_amdgcn_exp2f(st[k2][i] - m_run); st[k2][i] = pe; ps += pe; }
            l_run += ps;
#pragma unroll
            for (int ks2 = 0; ks2 < 4; ++ks2) {
                const bf16x8 pb = pack8(st[ks2 >> 1], ks2 & 1);
#pragma unroll
                for (int dt = 0; dt < DV / 32; ++dt) {
                    const bf16_t* vp = Vh + (32 * dt + l31) * LDV + 16 * ks2 + 4 * hh;
                    const bf16x8 a = ld_b64x2(vp, vp + 8);
                    O[dt] = MFMA32(a, pb, O[dt]);
                }
            }
        }
        }
    }
}

DI void attn_phase(const Params& p, const int j, char* lds, const int cidx) {
    unsigned char* ws = p.ws;
    const bf16_t* PROJ = (const bf16_t*)(ws + OFF_P);
    const bf16_t* VT = PROJ + (size_t)M_TOK * ATT_IN;
    bf16_t* MIX = (bf16_t*)(ws + OFF_HB);
    unsigned* counter = (unsigned*)(ws + OFF_CTRL) + cidx;
    int* s_item = (int*)(lds + LDS_BYTES - 16);
    const int tid = otid_w(p.wave), lane = tid & 63, w = tid >> 6, l31 = lane & 31, hh = lane >> 5;
    const float lambda_init = (j == 0) ? 0.2f : 0.4707130183435842f;
    float lam;
    {
        const float* lp = p.att_lambda + (size_t)j * 4 * 64;
        const float sa = wave_sum(lp[lane] * lp[64 + lane]), sb = wave_sum(lp[128 + lane] * lp[192 + lane]);
        lam = uni(__expf(sa) - __expf(sb) + lambda_init);
    }
    const float* subln = p.att_subln + (size_t)j * 128;
    for (;;) {
        if (tid == 0) *s_item = (int)atomicAdd(counter, 1u);
        __syncthreads();
        const int item = *s_item;
        __syncthreads();
        if (item >= 768) break;
        if (item < 256) {
            const int qt = 7 - (item >> 5), r = item & 31, b = r >> 2, h = r & 3;
            const int q0 = qt * 256;
            const size_t tokq = (size_t)(b * SEQ + q0 + w * 32 + l31);
            unsigned* O0s = (unsigned*)(lds + 53248) + tid;
#pragma unroll
            for (int sub = 0; sub < 2; ++sub) {
                bf16x8 qf[4];
#pragma unroll
                for (int ks = 0; ks < 4; ++ks) qf[ks] = *(const bf16x8*)(PROJ + tokq * ATT_IN + 1536 + (2 * h + sub) * 64 + ks * 16 + 8 * hh);
                f32x16 O[4];
#pragma unroll
                for (int dt = 0; dt < 4; ++dt)
#pragma unroll
                    for (int i = 0; i < 16; ++i) O[dt][i] = 0.f;
                float m_run = -1e29f, l_run = 0.f;
                attn_pass<128, false>(PROJ + (size_t)(b * SEQ) * ATT_IN + 2048 + (2 * h + sub) * 64, VT + (size_t)(b * 1024 + 512 + h * 128) * SEQ, qf, q0, O, m_run, l_run, lds, p.wave);
                const float lt = l_run + shx(l_run, 32);
                const float inv = 1.f / lt;
                if (sub == 0) {
#pragma unroll
                    for (int dt = 0; dt < 4; ++dt)
#pragma unroll
                        for (int i = 0; i < 8; ++i) O0s[(dt * 8 + i) * 512] = pk_bf16(O[dt][2 * i] * inv, O[dt][2 * i + 1] * inv);
                } else {
                    float ss = 0.f;
#pragma unroll
                    for (int dt = 0; dt < 4; ++dt)
#pragma unroll
                        for (int i = 0; i < 8; ++i) { const unsigned pw = O0s[(dt * 8 + i) * 512];
                            const float v0 = __uint_as_float(pw << 16) - lam * O[dt][2 * i] * inv, v1 = __uint_as_float(pw & 0xffff0000u) - lam * O[dt][2 * i + 1] * inv;
                            O[dt][2 * i] = v0; O[dt][2 * i + 1] = v1; ss += v0 * v0 + v1 * v1; }
                    ss += shx(ss, 32);
                    const float rs = rsqrtf(ss * (1.f / 128.f) + EPS) * (1.f - lambda_init);
                    bf16_t* dst = MIX + tokq * DM + 512 + h * 128;
#pragma unroll
                    for (int dt = 0; dt < 4; ++dt)
#pragma unroll
                        for (int g = 0; g < 4; ++g) { const int dv = 32 * dt + 8 * g + 4 * hh; const f32x4 gn = *(const f32x4*)(subln + dv);
                            u32x2 o; o[0] = pk_bf16(O[dt][4 * g] * rs * gn[0], O[dt][4 * g + 1] * rs * gn[1]); o[1] = pk_bf16(O[dt][4 * g + 2] * rs * gn[2], O[dt][4 * g + 3] * rs * gn[3]);
                            *(u32x2*)(dst + dv) = o; }
                }
            }
        } else {
            const int jj = item - 256;
            const int qt = 7 - (jj >> 6), r = jj & 63, b = r >> 3, h = r & 7;
            const int q0 = qt * 256;
            const size_t tokq = (size_t)(b * SEQ + q0 + w * 32 + l31);
            bf16x8 qf[4];
#pragma unroll
            for (int ks = 0; ks < 4; ++ks) qf[ks] = *(const bf16x8*)(PROJ + tokq * ATT_IN + h * 64 + ks * 16 + 8 * hh);
            f32x16 O[2];
#pragma unroll
            for (int dt = 0; dt < 2; ++dt)
#pragma unroll
                for (int i = 0; i < 16; ++i) O[dt][i] = 0.f;
            float m_run = -1e29f, l_run = 0.f;
            attn_pass<64, true>(PROJ + (size_t)(b * SEQ) * ATT_IN + 512 + h * 64, VT + (size_t)(b * 1024 + h * 64) * SEQ, qf, q0, O, m_run, l_run, lds, p.wave);
            const float lt = l_run + shx(l_run, 32);
            const float inv = 1.f / lt;
            bf16_t* dst = MIX + tokq * DM + h * 64;
#pragma unroll
            for (int dt = 0; dt < 2; ++dt)
#pragma unroll
                for (int g = 0; g < 4; ++g) { const int dv = 32 * dt + 8 * g + 4 * hh;
                    u32x2 o; o[0] = pk_bf16(O[dt][4 * g] * inv, O[dt][4 * g + 1] * inv); o[1] = pk_bf16(O[dt][4 * g + 2] * inv, O[dt][4 * g + 3] * inv);
                    *(u32x2*)(dst + dv) = o; }
        }
    }
}

template <bool FULL>
DI void hgrn_pass(const Params& p, const int j, char* lds) {
    unsigned char* ws = p.ws;
    const bf16_t* PROJ = (const bf16_t*)(ws + OFF_P);
    const bf16_t* IT = PROJ + (size_t)M_TOK * ATT_IN;
    const float* LOGF = (const float*)(ws + OFF_T);
    bf16_t* UB = (bf16_t*)(ws + OFF_U);
    float* DB = (float*)(ws + OFF_D);
    bf16_t* MIX = (bf16_t*)(ws + OFF_HB);
    const float* ggain = p.rec_gnorm + (size_t)j * 128;
    const int tid512 = otid_w(p.wave), grp = tid512 >> 8, tid = tid512 & 255, lane = tid & 63, w = tid >> 6, l31 = lane & 31, hh = lane >> 5;
    constexpr int LQ = 136, LV = 40, LO = 132;
    float* tot = (float*)(lds + grp * 57344);
    float* dvec = tot + 256;
    float* Bc = dvec + 128;
    float* Ot = Bc;
    bf16_t* Qh = (bf16_t*)(Bc + 32 * LO);
    bf16_t* Kt = Qh + 32 * LQ;
    bf16_t* KhT = Kt + 32 * LQ;
    bf16_t* VTs = KhT + 128 * LV;
    const int kk = tid & 127, half = tid >> 7;
    for (int item0 = obid() * 2; item0 < 512; item0 += ogrid() * 2) {
        const int item = item0 + grp, bh = item >> 3, seg = item & 7, b = bh >> 3, h = bh & 7;
        f32x16 S[4];
#pragma unroll
        for (int kt = 0; kt < 4; ++kt)
#pragma unroll
            for (int i = 0; i < 16; ++i) S[kt][i] = 0.f;
        if (FULL) {
            for (int i = 0; i < seg; ++i) {
                const bf16_t* U = UB + ((size_t)(bh * 8 + i) * 4 + w) * 4096 + lane * 16;
                const float* D = DB + (size_t)(bh * 8 + i) * 128;
#pragma unroll
                for (int kt = 0; kt < 4; ++kt) {
                    const u32x4 u0 = *(const u32x4*)(U + kt * 1024), u1 = *(const u32x4*)(U + kt * 1024 + 8);
#pragma unroll
                    for (int g = 0; g < 4; ++g) { const f32x4 dv = *(const f32x4*)(D + 32 * kt + 8 * g + 4 * hh);
                        const unsigned w0 = (g < 2) ? u0[2 * g] : u1[2 * (g - 2)], w1 = (g < 2) ? u0[2 * g + 1] : u1[2 * (g - 2) + 1];
                        S[kt][4 * g + 0] = S[kt][4 * g + 0] * dv[0] + __uint_as_float(w0 << 16);
                        S[kt][4 * g + 1] = S[kt][4 * g + 1] * dv[1] + __uint_as_float(w0 & 0xffff0000u);
                        S[kt][4 * g + 2] = S[kt][4 * g + 2] * dv[2] + __uint_as_float(w1 << 16);
                        S[kt][4 * g + 3] = S[kt][4 * g + 3] * dv[3] + __uint_as_float(w1 & 0xffff0000u); }
                }
            }
        }
        const size_t rowS = (size_t)b * SEQ + seg * 256;
        float segsum = 0.f;
        float lf[16]; u32x4 kq[2], qq[2], vv[2];
#define H_LOADS(c) do { const size_t r0_ = rowS + (c) * 32; \
            _Pragma("unroll") for (int t = 0; t < 16; ++t) lf[t] = LOGF[(r0_ + 16 * half + t) * DM + h * 128 + kk]; \
            _Pragma("unroll") for (int i = 0; i < 2; ++i) { const int ci = tid + 256 * i, t = ci >> 4, k8 = (ci & 15) * 8; \
                kq[i] = *(const u32x4*)(PROJ + (r0_ + t) * ATT_IN + 1024 + h * 128 + k8); if (FULL) qq[i] = *(const u32x4*)(PROJ + (r0_ + t) * ATT_IN + h * 128 + k8); } \
            _Pragma("unroll") for (int i = 0; i < 2; ++i) { const int ci = tid + 256 * i, v = ci >> 2, s8 = (ci & 3) * 8; \
                vv[i] = *(const u32x4*)(IT + (size_t)(b * 1024 + h * 128 + v) * SEQ + seg * 256 + (c) * 32 + s8); } } while (0)
        H_LOADS(0);
        for (int c = 0; c < 8; ++c) {
            const size_t row0 = rowS + c * 32;
            float bc[16];
            {
                float run = 0.f;
#pragma unroll
                for (int t = 0; t < 16; ++t) { run += lf[t]; bc[t] = run; }
                tot[half * 128 + kk] = run;
            }
            __syncthreads();
            {
                const float t0v = tot[kk], t1v = tot[128 + kk];
                const float blast = t0v + t1v;
                const float add = half ? t0v : 0.f;
                if (half == 0) { dvec[kk] = __expf(blast); segsum += blast; }
#pragma unroll
                for (int t = 0; t < 16; ++t) Bc[(16 * half + t) * LO + kk] = bc[t] + add;
            }
            __syncthreads();
#pragma unroll
            for (int i = 0; i < 2; ++i) {
                const int ci = tid + 256 * i, t = ci >> 4, k8 = (ci & 15) * 8;
                const f32x4 b0 = *(const f32x4*)(Bc + t * LO + k8), b1 = *(const f32x4*)(Bc + t * LO + k8 + 4);
                const f32x4 ta = *(const f32x4*)(tot + k8), tb = *(const f32x4*)(tot + k8 + 4), tc = *(const f32x4*)(tot + 128 + k8), td = *(const f32x4*)(tot + 128 + k8 + 4);
                float bcv[8], blv[8], kf[8], qf[8];
#pragma unroll
                for (int e = 0; e < 4; ++e) { bcv[e] = b0[e]; bcv[4 + e] = b1[e]; blv[e] = ta[e] + tc[e]; blv[4 + e] = tb[e] + td[e]; }
#pragma unroll
                for (int e = 0; e < 4; ++e) { kf[2 * e] = __uint_as_float(kq[i][e] << 16); kf[2 * e + 1] = __uint_as_float(kq[i][e] & 0xffff0000u); }
#pragma unroll
                for (int e = 0; e < 8; ++e) KhT[(k8 + (e ^ ((k8 >> 3) & 7))) * LV + t] = f2bf(kf[e] * __expf(blv[e] - bcv[e]));
                if (FULL) {
#pragma unroll
                    for (int e = 0; e < 4; ++e) { qf[2 * e] = __uint_as_float(qq[i][e] << 16); qf[2 * e + 1] = __uint_as_float(qq[i][e] & 0xffff0000u); }
                    u32x4 oq, ok;
#pragma unroll
                    for (int e = 0; e < 4; ++e) {
                        oq[e] = pk_bf16(qf[2 * e] * __expf(bcv[2 * e]), qf[2 * e + 1] * __expf(bcv[2 * e + 1]));
                        ok[e] = pk_bf16(kf[2 * e] * __expf(-bcv[2 * e]), kf[2 * e + 1] * __expf(-bcv[2 * e + 1])); }
                    *(u32x4*)(Qh + t * LQ + k8) = oq; *(u32x4*)(Kt + t * LQ + k8) = ok;
                }
            }
#pragma unroll
            for (int i = 0; i < 2; ++i) { const int ci = tid + 256 * i, v = ci >> 2, s8 = (ci & 3) * 8; *(u32x4*)(VTs + v * LV + s8) = vv[i]; }
            u32x4 gg0, gg1;
            if (FULL) { const int t = tid >> 3, sg = tid & 7; const bf16_t* gp = PROJ + (row0 + t) * ATT_IN + 2048 + h * 128 + sg * 16; gg0 = *(const u32x4*)gp; gg1 = *(const u32x4*)(gp + 8); }
            if (c + 1 < 8) H_LOADS(c + 1);
            __syncthreads();
            f32x16 o;
            if (FULL) {
                f32x16 at;
#pragma unroll
                for (int i = 0; i < 16; ++i) at[i] = 0.f;
#pragma unroll
                for (int ks = 0; ks < 8; ++ks) { const bf16x8 a = *(const bf16x8*)(Kt + l31 * LQ + ks * 16 + 8 * hh); const bf16x8 bq = *(const bf16x8*)(Qh + l31 * LQ + ks * 16 + 8 * hh); at = MFMA32(a, bq, at); }
#pragma unroll
                for (int i = 0; i < 16; ++i) at[i] = (crow(i, hh) <= l31) ? at[i] : 0.f;
#pragma unroll
                for (int i = 0; i < 16; ++i) o[i] = 0.f;
#pragma unroll
                for (int kt = 0; kt < 4; ++kt)
#pragma unroll
                    for (int s2 = 0; s2 < 2; ++s2) { const bf16_t* qp = Qh + l31 * LQ + 32 * kt + 16 * s2 + 4 * hh; const bf16x8 aq = ld_b64x2(qp, qp + 8); const bf16x8 bs = pack8(S[kt], s2); o = MFMA32(aq, bs, o); }
#pragma unroll
                for (int s2 = 0; s2 < 2; ++s2) { const bf16_t* vp = VTs + (32 * w + l31) * LV + 16 * s2 + 4 * hh; const bf16x8 bv = ld_b64x2(vp, vp + 8); const bf16x8 pa = pack8(at, s2); o = MFMA32(pa, bv, o); }
            }
#pragma unroll
            for (int kt = 0; kt < 4; ++kt) {
#pragma unroll
                for (int g = 0; g < 4; ++g) { const f32x4 dv = *(const f32x4*)(dvec + 32 * kt + 8 * g + 4 * hh);
                    S[kt][4 * g] *= dv[0]; S[kt][4 * g + 1] *= dv[1]; S[kt][4 * g + 2] *= dv[2]; S[kt][4 * g + 3] *= dv[3]; }
#pragma unroll
                for (int s2 = 0; s2 < 2; ++s2) { const int kr_ = 32 * kt + l31; const bf16x8 a = *(const bf16x8*)(KhT + (kr_ ^ ((kr_ >> 3) & 7)) * LV + 16 * s2 + 8 * hh); const bf16x8 bv = *(const bf16x8*)(VTs + (32 * w + l31) * LV + 16 * s2 + 8 * hh); S[kt] = MFMA32(a, bv, S[kt]); }
            }
            if (FULL) {
#pragma unroll
                for (int i = 0; i < 16; ++i) Ot[crow(i, hh) * LO + 32 * w + l31] = o[i];
                __syncthreads();
                const int t = tid >> 3, sg = tid & 7;
                f32x4 ov[4]; float ss = 0.f;
#pragma unroll
                for (int q = 0; q < 4; ++q) { ov[q] = *(const f32x4*)(Ot + t * LO + sg * 16 + 4 * q); ss += ov[q][0] * ov[q][0] + ov[q][1] * ov[q][1] + ov[q][2] * ov[q][2] + ov[q][3] * ov[q][3]; }
                ss += shx(ss, 1); ss += shx(ss, 2); ss += shx(ss, 4);
                const float rs = rsqrtf(ss * (1.f / 128.f) + EPS);
                float gt[16];
#pragma unroll
                for (int e = 0; e < 4; ++e) { gt[2 * e] = __uint_as_float(gg0[e] << 16); gt[2 * e + 1] = __uint_as_float(gg0[e] & 0xffff0000u);
                    gt[8 + 2 * e] = __uint_as_float(gg1[e] << 16); gt[8 + 2 * e + 1] = __uint_as_float(gg1[e] & 0xffff0000u); }
                float res[16];
#pragma unroll
                for (int q = 0; q < 4; ++q) { const f32x4 gn = *(const f32x4*)(ggain + sg * 16 + 4 * q);
#pragma unroll
                    for (int e = 0; e < 4; ++e) res[4 * q + e] = ov[q][e] * rs * gn[e] * gt[4 * q + e]; }
                u32x4 o0, o1;
#pragma unroll
                for (int e = 0; e < 4; ++e) { o0[e] = pk_bf16(res[2 * e], res[2 * e + 1]); o1[e] = pk_bf16(res[8 + 2 * e], res[8 + 2 * e + 1]); }
                bf16_t* dst = MIX + (row0 + t) * DM + h * 128 + sg * 16;
                *(u32x4*)dst = o0; *(u32x4*)(dst + 8) = o1;
            }
        }
#undef H_LOADS
        if (!FULL) {
            bf16_t* U = UB + ((size_t)item * 4 + w) * 4096 + lane * 16;
#pragma unroll
            for (int kt = 0; kt < 4; ++kt) {
                u32x4 u0, u1;
#pragma unroll
                for (int e = 0; e < 4; ++e) { u0[e] = pk_bf16(S[kt][2 * e], S[kt][2 * e + 1]); u1[e] = pk_bf16(S[kt][8 + 2 * e], S[kt][8 + 2 * e + 1]); }
                *(u32x4*)(U + kt * 1024) = u0; *(u32x4*)(U + kt * 1024 + 8) = u1;
            }
            if (half == 0) DB[(size_t)item * 128 + kk] = __expf(segsum);
        }
        __syncthreads();
    }
}

#define XB_TMO      128
#define XB_XCNT(j)  (256  + 64 * (j))
#define XB_XSUB(j)  (1280 + 64 * (j))
#define XB_XGEN(j)  (2304 + 64 * (j))
#define XB_TOP      3328
#define XB_TOPGEN   3392
#define XCD_BAR_WORDS 3456
#define XB_SPIN_CAP (1u << 18)
#define LAS __attribute__((address_space(3)))
DI unsigned xb_ld(unsigned* p)              { return __hip_atomic_load(p, __ATOMIC_RELAXED, __HIP_MEMORY_SCOPE_AGENT); }
DI unsigned xb_add(unsigned* p, unsigned v) { return __hip_atomic_fetch_add(p, v, __ATOMIC_RELAXED, __HIP_MEMORY_SCOPE_AGENT); }
DI unsigned xb_xcc_id() { return (unsigned)__builtin_amdgcn_s_getreg((3 << 11) | 20) & 0xFu; }
#define XB_SPIN(cond, bar) do { unsigned _sp = 0; while (cond) { __builtin_amdgcn_s_sleep(1); \
    if ((++_sp & 255u) == 0u) { if (xb_ld(&(bar)[XB_TMO])) break; if (_sp > XB_SPIN_CAP) { atomicAdd(&(bar)[XB_TMO], 1u); break; } } } } while (0)
struct XcdBarrier { unsigned* bar; unsigned x; volatile LAS unsigned* st; };
DI XcdBarrier xcd_barrier_post(unsigned* bar, volatile LAS unsigned* st, const int gw) {
    XcdBarrier b; b.bar = bar; b.x = xb_xcc_id(); b.st = st;
    if (gw == 0 && olane() == 0) (void)xb_add(&bar[XB_XCNT(b.x)], 1u);
    return b;
}
DI void xcd_barrier_complete(unsigned* bar, unsigned x, unsigned& nloc, unsigned& nx) {
    const unsigned G = gridDim.x * gridDim.y * gridDim.z;
    unsigned sum, cnt, mine, sp = 0u;
    for (;;) {
        sum = 0u; cnt = 0u; mine = 0u;
#pragma unroll
        for (unsigned j = 0; j < 16; ++j) { const unsigned c = xb_ld(&bar[XB_XCNT(j)]); sum += c; cnt += (c > 0u) ? 1u : 0u; mine = (j == x) ? c : mine; }
        if (sum == G) break;
        __builtin_amdgcn_s_sleep(1);
        if ((++sp & 255u) == 0u) { if (xb_ld(&bar[XB_TMO])) break; if (sp > XB_SPIN_CAP) { atomicAdd(&bar[XB_TMO], 1u); break; } }
    }
    nloc = mine > 0u ? mine : 1u; nx = cnt > 0u ? cnt : 1u;
}
DI void xcd_barrier(const XcdBarrier& b, const int gw) {
    asm volatile("s_waitcnt vmcnt(0)" ::: "memory");
    __syncthreads();
    if (gw == 0 && olane() == 0) {
        unsigned* bar = b.bar;
        __builtin_amdgcn_s_waitcnt(0);
        unsigned nloc = b.st[0], nx = b.st[1];
        if (nloc == 0u) { xcd_barrier_complete(bar, b.x, nloc, nx); b.st[0] = nloc; b.st[1] = nx; }
        const unsigned old = xb_add(&bar[XB_XSUB(b.x)], 1u);
        const unsigned gen = old / nloc;
        if (old + 1u == (gen + 1u) * nloc) {
            __builtin_amdgcn_fence(__ATOMIC_RELEASE, "agent");
            asm volatile("s_waitcnt vmcnt(0)" ::: "memory");
            const unsigned og = xb_add(&bar[XB_TOP], 1u);
            const unsigned tg = og / nx;
            if (og + 1u == (tg + 1u) * nx) xb_add(&bar[XB_TOPGEN], 1u);
            else XB_SPIN(xb_ld(&bar[XB_TOPGEN]) == tg, bar);
            __builtin_amdgcn_fence(__ATOMIC_ACQUIRE, "agent");
            xb_add(&bar[XB_XGEN(b.x)], 1u);
            asm volatile("s_waitcnt vmcnt(0)" ::: "memory");
        } else {
            XB_SPIN(xb_ld(&bar[XB_XGEN(b.x)]) == gen, bar);
            __builtin_amdgcn_fence(__ATOMIC_ACQUIRE, "agent");
            asm volatile("s_waitcnt vmcnt(0)" ::: "memory");
        }
    }
    __syncthreads();
}

#ifndef PROBE_DUP
#define PROBE_DUP 0
#endif
#if PROBE_DUP == 1
constexpr int NST = 11; constexpr unsigned long long SEQ64 = 0x65544322100ull; constexpr int NPRE = 1;
#elif PROBE_DUP == 2
constexpr int NST = 8; constexpr unsigned long long SEQ64 = 0x65432110ull; constexpr int NPRE = 1;
#elif PROBE_DUP == 8
constexpr int NST = 7; constexpr unsigned long long SEQ64 = 0x6543210ull; constexpr int NPRE = 2;
#else
constexpr int NST = 7; constexpr unsigned long long SEQ64 = 0x6543210ull; constexpr int NPRE = 1;
#endif
constexpr int NPH = NPRE + 4 * NST;
__global__ void __launch_bounds__(NTHREADS) fwd_kernel(Params p) {
    __shared__ __attribute__((aligned(16))) char lds[LDS_BYTES];
    cg::grid_group grid = cg::this_grid();
    __shared__ __attribute__((aligned(16))) unsigned xb_words[4];
    if (threadIdx.x < 4) xb_words[threadIdx.x] = 0u;
    __syncthreads();
    const int g_wave = __builtin_amdgcn_readfirstlane((int)(threadIdx.x >> 6));
    (void)xcd_barrier_post((unsigned*)(p.ws + OFF_BAR), (volatile LAS unsigned*)&xb_words, g_wave);
#define XBAR() do { XcdBarrier xb_; xb_.bar = (unsigned*)(p.ws + OFF_BAR); xb_.x = xb_xcc_id(); xb_.st = (volatile LAS unsigned*)&xb_words; xcd_barrier(xb_, g_wave); } while (0)
    for (int ph = p.ph_lo; ph < p.ph_hi; ++ph) {
        Params q = p; q.wave = g_wave;
        asm volatile("" : "+s"(q.ws), "+s"(q.out), "+s"(q.x), "+s"(q.norm_gains));
        unsigned char* ws = q.ws;
        if (ph < NPRE) {
            prep_phase(q, lds);
        } else {
            const int L = (ph - NPRE) / NST, st = (int)((SEQ64 >> (4 * ((ph - NPRE) % NST))) & 15ull), j = L >> 1;
            const float* gains = q.norm_gains + (size_t)L * 4 * DM;
            const bf16_t* HB = (const bf16_t*)(ws + OFF_HB);
            switch (st) {
            case 0:
                if ((L & 1) == 0) gemm_phase<EPI_ATT_IN>(HB, (const bf16_t*)(ws + OFF_ATT_IN_T) + (size_t)j * ATT_IN * DM, DM, ATT_IN, q, j, lds);
                else gemm_phase<EPI_REC_IN>(HB, (const bf16_t*)(ws + OFF_REC_IN_T) + (size_t)j * REC_IN * DM, DM, REC_IN, q, j, lds);
                break;
            case 1:
                if ((L & 1) == 0) attn_phase(q, j, lds, ph); else { hgrn_pass<false>(q, j, lds); XBAR(); hgrn_pass<true>(q, j, lds); }
                break;
            case 2: case 5: {
                const bf16_t* Ap = (st == 2) ? HB : (const bf16_t*)(ws + OFF_P);
                const bf16_t* Bp = (st == 2) ? (((L & 1) == 0) ? (const bf16_t*)(ws + OFF_ATT_OUT_T) + (size_t)j * DM * DM : (const bf16_t*)(ws + OFF_REC_OUT_T) + (size_t)j * DM * DM)
                                             : (const bf16_t*)(ws + OFF_FFN_OUT_T) + (size_t)L * DM * FFN_H;
                gemm_phase<EPI_F32>(Ap, Bp, (st == 2) ? DM : FFN_H, DM, q, j, lds);
                break; }
            case 3:
                row_phase((const bf16_t*)(ws + OFF_T), L == 0 ? q.x : q.out, q.out, gains + DM, gains + 2 * DM, (bf16_t*)(ws + OFF_HB), q.wave);
                break;
            case 4:
                gemm_phase<EPI_FFN_IN>(HB, (const bf16_t*)(ws + OFF_FFN_IN_T) + (size_t)L * FFN_IN * DM, DM, FFN_IN, q, j, lds);
                if (L < 3) { const int rem_ = ((M_TOK / 256) * (FFN_IN / 256)) % ogrid();
                    if (obid() >= rem_) convert_layer_weights(q, L + 1, obid() - rem_, ogrid() - rem_, lds, 2); }
                break;
            default:
                row_phase((const bf16_t*)(ws + OFF_T), q.out, q.out, gains + 3 * DM, L < 3 ? gains + 4 * DM : nullptr, L < 3 ? (bf16_t*)(ws + OFF_HB) : nullptr, q.wave);
                break;
            }
        }
        if (ph + 1 < p.ph_hi) { if (p.ph_hi < 0) grid.sync(); else XBAR(); }
    }
}

#ifndef ONE_LAUNCH
#define ONE_LAUNCH 1
#endif

extern "C" void kernel_launch(void* const* d_in, const int* in_sizes, int n_in, void* d_out, int out_size, void* d_ws, size_t ws_size, hipStream_t stream) {
    static int grid_blocks = 0;
    if (!grid_blocks) {
        int dev = 0, cus = 0, per_cu = 0;
        hipGetDevice(&dev);
        hipDeviceGetAttribute(&cus, hipDeviceAttributeMultiprocessorCount, dev);
        hipOccupancyMaxActiveBlocksPerMultiprocessor(&per_cu, fwd_kernel, NTHREADS, 0);
        if (per_cu > 1) per_cu = 1;
        grid_blocks = cus * per_cu;
        if (ws_size < WS_NEED) { fprintf(stderr, "workspace too small: %zu < %zu\n", ws_size, (size_t)WS_NEED); grid_blocks = 0; return; }
    }
    Params p{};
    p.x = (const float*)d_in[0]; p.norm_gains = (const float*)d_in[1]; p.att_w_in = (const float*)d_in[2]; p.att_lambda = (const float*)d_in[3];
    p.att_subln = (const float*)d_in[4]; p.att_w_out = (const float*)d_in[5]; p.rec_w_in = (const float*)d_in[6]; p.rec_lb = (const float*)d_in[7];
    p.rec_gnorm = (const float*)d_in[8]; p.rec_w_out = (const float*)d_in[9]; p.ffn_w_in = (const float*)d_in[10]; p.ffn_w_out = (const float*)d_in[11];
    p.out = (float*)d_out; p.ws = (unsigned char*)d_ws;
    hipMemsetAsync((char*)d_ws + OFF_BAR, 0, 16384, stream);
#if ONE_LAUNCH
    p.ph_lo = 0; p.ph_hi = NPH;
    void* args[] = {&p};
    hipError_t e = hipLaunchCooperativeKernel((void*)fwd_kernel, dim3(grid_blocks), dim3(NTHREADS), args, 0, stream);
    if (e != hipSuccess) fprintf(stderr, "cooperative launch failed: %s (grid %d)\n", hipGetErrorString(e), grid_blocks);
#else
    for (int ph = 0; ph < NPH; ++ph) {
        p.ph_lo = ph; p.ph_hi = ph + 1;
        void* args[] = {&p};
        hipLaunchCooperativeKernel((void*)fwd_kernel, dim3(grid_blocks), dim3(NTHREADS), args, 0, stream);
    }
#endif
}
```

```cpp
#include <hip/hip_runtime.h>
#include <hip/hip_cooperative_groups.h>
#include <cstdio>
#include <cstdint>
namespace cg = cooperative_groups;

typedef unsigned short bf16_t;
typedef short bf16x8 __attribute__((ext_vector_type(8)));
typedef short s16x4 __attribute__((ext_vector_type(4)));
typedef float f32x16 __attribute__((ext_vector_type(16)));
typedef float f32x4 __attribute__((ext_vector_type(4)));
typedef unsigned u32x4 __attribute__((ext_vector_type(4)));
typedef unsigned u32x2 __attribute__((ext_vector_type(2)));
typedef __bf16 bf16x2_t __attribute__((ext_vector_type(2)));
typedef float f32x2_t __attribute__((ext_vector_type(2)));

#define DI __device__ __forceinline__
#define MFMA32(a, b, c) __builtin_amdgcn_mfma_f32_32x32x16_bf16((a), (b), (c), 0, 0, 0)

constexpr int NTHREADS = 512;
constexpr int M_TOK = 16384, DM = 1024, SEQ = 2048, NB = 8;
constexpr int ATT_IN = 3072, REC_IN = 4096, FFN_H = 2816, FFN_IN = 5632;
constexpr float EPS = 1e-6f;
constexpr float LOG2E = 1.4426950408889634f;
constexpr int LDS_BYTES = 131072 + 64;

constexpr size_t OFF_CTRL = 0;
constexpr size_t OFF_ROPE = 4096;
constexpr size_t OFF_WT = OFF_ROPE + 2 * 2048 * 32 * 4;
constexpr size_t N_ATT_IN_T = (size_t)2 * ATT_IN * DM;
constexpr size_t N_ATT_OUT_T = (size_t)2 * DM * DM;
constexpr size_t N_REC_IN_T = (size_t)2 * REC_IN * DM;
constexpr size_t N_REC_OUT_T = (size_t)2 * DM * DM;
constexpr size_t N_FFN_IN_T = (size_t)4 * FFN_IN * DM;
constexpr size_t N_FFN_OUT_T = (size_t)4 * DM * FFN_H;
constexpr size_t OFF_ATT_IN_T = OFF_WT;
constexpr size_t OFF_ATT_OUT_T = OFF_ATT_IN_T + N_ATT_IN_T * 2;
constexpr size_t OFF_REC_IN_T = OFF_ATT_OUT_T + N_ATT_OUT_T * 2;
constexpr size_t OFF_REC_OUT_T = OFF_REC_IN_T + N_REC_IN_T * 2;
constexpr size_t OFF_FFN_IN_T = OFF_REC_OUT_T + N_REC_OUT_T * 2;
constexpr size_t OFF_FFN_OUT_T = OFF_FFN_IN_T + N_FFN_IN_T * 2;
constexpr size_t OFF_HB = OFF_FFN_OUT_T + N_FFN_OUT_T * 2;
constexpr size_t OFF_P = OFF_HB + (size_t)M_TOK * DM * 2;
constexpr size_t OFF_T = OFF_P + (size_t)M_TOK * 4096 * 2;
constexpr size_t OFF_U = OFF_T + (size_t)M_TOK * DM * 4;
constexpr size_t OFF_D = OFF_U + (size_t)512 * 16384 * 2;
constexpr size_t OFF_BAR = OFF_D + (size_t)512 * 128 * 4;
constexpr size_t WS_NEED = OFF_BAR + 16384;

struct Params {
    const float* x; const float* norm_gains; const float* att_w_in; const float* att_lambda; const float* att_subln;
    const float* att_w_out; const float* rec_w_in; const float* rec_lb; const float* rec_gnorm; const float* rec_w_out;
    const float* ffn_w_in; const float* ffn_w_out;
    float* out; unsigned char* ws;
    int ph_lo, ph_hi;
    int wave, pad0;
};

DI int obid() { int b = blockIdx.x; asm volatile("" : "+s"(b)); return b; }
DI int ogrid() { int g = gridDim.x; asm volatile("" : "+s"(g)); return g; }
DI int olane() { int l; asm volatile("v_mbcnt_lo_u32_b32 %0, -1, 0\n\tv_mbcnt_hi_u32_b32 %0, -1, %0" : "=v"(l)); return l; }
DI int otid_w(int gw) { return (gw << 6) | olane(); }
DI unsigned pk_bf16(float a, float b) { f32x2_t v = {a, b}; bf16x2_t r = __builtin_convertvector(v, bf16x2_t); return __builtin_bit_cast(unsigned, r); }
DI float bf2f(bf16_t u) { return __uint_as_float(((unsigned)u) << 16); }
DI bf16_t f2bf(float a) { return (bf16_t)(pk_bf16(a, 0.f) & 0xffffu); }
DI int crow(int i, int h) { return (i & 3) + 8 * (i >> 2) + 4 * h; }
DI float shx(float v, int mask) { const int l = olane(); return __builtin_bit_cast(float, __builtin_amdgcn_ds_bpermute(((l ^ mask) & 63) << 2, __builtin_bit_cast(int, v))); }
DI float oconst(float c) { asm volatile("" : "+v"(c)); return c; }
DI float uni(float x) { return __builtin_bit_cast(float, __builtin_amdgcn_readfirstlane(__builtin_bit_cast(int, x))); }
DI float wave_sum(float v) {
#pragma unroll
    for (int o = 32; o >= 1; o >>= 1) v += shx(v, o);
    return v;
}
DI float silu_f(float x) { return x * __builtin_amdgcn_rcpf(1.f + __expf(-x)); }
DI bf16x8 pack8(const f32x16& x, int s) {
    u32x4 p;
    p[0] = pk_bf16(x[8 * s + 0], x[8 * s + 1]); p[1] = pk_bf16(x[8 * s + 2], x[8 * s + 3]);
    p[2] = pk_bf16(x[8 * s + 4], x[8 * s + 5]); p[3] = pk_bf16(x[8 * s + 6], x[8 * s + 7]);
    return __builtin_bit_cast(bf16x8, p);
}
DI bf16x8 ld_b64x2(const bf16_t* p0, const bf16_t* p1) {
    u32x2 a = *(const u32x2*)p0, b = *(const u32x2*)p1;
    u32x4 r; r[0] = a[0]; r[1] = a[1]; r[2] = b[0]; r[3] = b[1];
    return __builtin_bit_cast(bf16x8, r);
}

DI void transpose_tiles(const float* src, bf16_t* dst, int K, int N, bool perm, int& tile_base, char* lds, const int gw, const int vbid, const int vgrid) {
    const int tid512 = otid_w(gw), half = tid512 >> 8, tid = tid512 & 255;
    float* tl = (float*)lds + half * (64 * 65);
    const int tk = K / 64, tn = N / 64, nt = tk * tn;
    const int vb = vbid * 2 + half, nvb = vgrid * 2;
    int first = (vb - tile_base) % nvb; if (first < 0) first += nvb;
    const int iters = (nt + nvb - 1) / nvb;
    f32x4 rv[4];
#define TT_LOAD(T) do { if ((T) < nt) { const int kb_ = ((T) % tk) * 64, nb_ = ((T) / tk) * 64; \
        _Pragma("unroll") for (int i = 0; i < 4; ++i) { const int kl = (tid >> 4) + 16 * i, np = nb_ + (tid & 15) * 4; \
            const int rho_ = np & 31, lo5_ = perm ? (8 * ((rho_ & 15) >> 2) + 4 * (rho_ >> 4) + (rho_ & 3)) : rho_;     \
            const int nq = (np & ~255) | (((np >> 5) & 3) << 6) | (((np >> 7) & 1) << 5) | lo5_;     \
            const int sc = perm ? (((nq >> 5) & 1) * FFN_H + (nq >> 6) * 32 + (nq & 31)) : nq; \
            rv[i] = *(const f32x4*)(src + (size_t)(kb_ + kl) * N + sc); } } } while (0)
    TT_LOAD(first);
    for (int it = 0; it < iters; ++it) {
        const int t = first + it * nvb; const bool act = t < nt;
        const int kb = (t % tk) * 64, nb = (t / tk) * 64;
        __syncthreads();
        if (act) {
#pragma unroll
            for (int i = 0; i < 4; ++i) { const int kl = (tid >> 4) + 16 * i, n4 = (tid & 15) * 4;
                tl[kl * 65 + n4 + 0] = rv[i][0]; tl[kl * 65 + n4 + 1] = rv[i][1]; tl[kl * 65 + n4 + 2] = rv[i][2]; tl[kl * 65 + n4 + 3] = rv[i][3]; }
        }
        __syncthreads();
        TT_LOAD(t + nvb);
        if (act) {
            const int nl = tid >> 2, ks = (tid & 3) * 16;
            u32x4 o0, o1;
#pragma unroll
            for (int j = 0; j < 4; ++j) {
                o0[j] = pk_bf16(tl[(ks + 2 * j) * 65 + nl], tl[(ks + 2 * j + 1) * 65 + nl]);
                o1[j] = pk_bf16(tl[(ks + 8 + 2 * j) * 65 + nl], tl[(ks + 8 + 2 * j + 1) * 65 + nl]);
            }
            bf16_t* d = dst + (size_t)(nb + nl) * K + kb + ks;
            *(u32x4*)d = o0; *(u32x4*)(d + 8) = o1;
        }
    }
#undef TT_LOAD
    tile_base = (tile_base + nt) % nvb;
}

DI void row_phase(const bf16_t* msrc, const float* xsrc, float* xdst, const float* g_post, const float* g_next, bf16_t* hdst, const int gw) {
    constexpr int RB = 4;
    const int tid = otid_w(gw); const int lane = tid & 63, w = tid >> 6;
    const int wg = obid() * 8 + w, nw = ogrid() * 8;
    for (int rowb = wg * RB; rowb < M_TOK; rowb += nw * RB) {
        f32x4 xv[RB][4], mv[RB][4];
#pragma unroll
        for (int r = 0; r < RB; ++r)
#pragma unroll
            for (int j = 0; j < 4; ++j) xv[r][j] = *(const f32x4*)(xsrc + (size_t)(rowb + r) * DM + lane * 4 + 256 * j);
        if (msrc) {
#pragma unroll
            for (int r = 0; r < RB; ++r)
#pragma unroll
                for (int j = 0; j < 4; ++j) { const u32x2 mw = *(const u32x2*)(msrc + (size_t)(rowb + r) * DM + lane * 4 + 256 * j);
                    mv[r][j] = (f32x4){__uint_as_float(mw[0] << 16), __uint_as_float(mw[0] & 0xffff0000u), __uint_as_float(mw[1] << 16), __uint_as_float(mw[1] & 0xffff0000u)}; }
            float ss[RB];
#pragma unroll
            for (int r = 0; r < RB; ++r) { ss[r] = 0.f;
#pragma unroll
                for (int j = 0; j < 4; ++j) ss[r] += mv[r][j][0] * mv[r][j][0] + mv[r][j][1] * mv[r][j][1] + mv[r][j][2] * mv[r][j][2] + mv[r][j][3] * mv[r][j][3]; }
#pragma unroll
            for (int o = 32; o >= 1; o >>= 1)
#pragma unroll
                for (int r = 0; r < RB; ++r) ss[r] += shx(ss[r], o);
#pragma unroll
            for (int j = 0; j < 4; ++j) { const f32x4 g = *(const f32x4*)(g_post + lane * 4 + 256 * j);
#pragma unroll
                for (int r = 0; r < RB; ++r) { const float r1 = rsqrtf(ss[r] * (1.f / DM) + EPS); xv[r][j] = xv[r][j] + mv[r][j] * r1 * g; *(f32x4*)(xdst + (size_t)(rowb + r) * DM + lane * 4 + 256 * j) = xv[r][j]; } }
        }
        if (hdst) {
            float ss[RB];
#pragma unroll
            for (int r = 0; r < RB; ++r) { ss[r] = 0.f;
#pragma unroll
                for (int j = 0; j < 4; ++j) ss[r] += xv[r][j][0] * xv[r][j][0] + xv[r][j][1] * xv[r][j][1] + xv[r][j][2] * xv[r][j][2] + xv[r][j][3] * xv[r][j][3]; }
#pragma unroll
            for (int o = 32; o >= 1; o >>= 1)
#pragma unroll
                for (int r = 0; r < RB; ++r) ss[r] += shx(ss[r], o);
#pragma unroll
            for (int j = 0; j < 4; ++j) { const f32x4 g = *(const f32x4*)(g_next + lane * 4 + 256 * j);
#pragma unroll
                for (int r = 0; r < RB; ++r) { const float r2 = rsqrtf(ss[r] * (1.f / DM) + EPS); const f32x4 hv = xv[r][j] * r2 * g;
                    u32x2 o; o[0] = pk_bf16(hv[0], hv[1]); o[1] = pk_bf16(hv[2], hv[3]); *(u32x2*)(hdst + (size_t)(rowb + r) * DM + lane * 4 + 256 * j) = o; } }
        }
    }
}

DI void convert_layer_weights(const Params& p, const int L, const int vbid, const int vgrid, char* lds, const int which  ) {
    unsigned char* ws = p.ws;
    const int j = L >> 1;
    int tb = 0;
    if ((which & 1) == 0) {
    } else if ((L & 1) == 0) {
        transpose_tiles(p.att_w_in + (size_t)j * DM * ATT_IN, (bf16_t*)(ws + OFF_ATT_IN_T) + (size_t)j * ATT_IN * DM, DM, ATT_IN, false, tb, lds, p.wave, vbid, vgrid);
        transpose_tiles(p.att_w_out + (size_t)j * DM * DM, (bf16_t*)(ws + OFF_ATT_OUT_T) + (size_t)j * DM * DM, DM, DM, false, tb, lds, p.wave, vbid, vgrid);
    } else {
        transpose_tiles(p.rec_w_in + (size_t)j * DM * REC_IN, (bf16_t*)(ws + OFF_REC_IN_T) + (size_t)j * REC_IN * DM, DM, REC_IN, false, tb, lds, p.wave, vbid, vgrid);
        transpose_tiles(p.rec_w_out + (size_t)j * DM * DM, (bf16_t*)(ws + OFF_REC_OUT_T) + (size_t)j * DM * DM, DM, DM, false, tb, lds, p.wave, vbid, vgrid);
    }
    if (which & 2) {
    transpose_tiles(p.ffn_w_in + (size_t)L * DM * FFN_IN, (bf16_t*)(ws + OFF_FFN_IN_T) + (size_t)L * FFN_IN * DM, DM, FFN_IN, true, tb, lds, p.wave, vbid, vgrid);
    transpose_tiles(p.ffn_w_out + (size_t)L * FFN_H * DM, (bf16_t*)(ws + OFF_FFN_OUT_T) + (size_t)L * DM * FFN_H, FFN_H, DM, false, tb, lds, p.wave, vbid, vgrid);
    }
}

DI void prep_phase(const Params& p, char* lds) {
    unsigned char* ws = p.ws;
    const int ptid = otid_w(p.wave);
    if (obid() == 0 && ptid < 64) ((unsigned*)(ws + OFF_CTRL))[ptid] = 0u;
    {
        float* cosT = (float*)(ws + OFF_ROPE); float* sinT = cosT + 2048 * 32;
        for (int idx = obid() * NTHREADS + ptid; idx < 2048 * 32; idx += ogrid() * NTHREADS) {
            const int pos = idx >> 5, i = idx & 31;
            const float inv_freq = __builtin_amdgcn_exp2f(-(float)i * (13.287712379549449f / 32.f));
            const float ang = (float)pos * inv_freq;
            const float n = rintf(ang * 0.15915494309189535f);
            float r = fmaf(-n, 6.28125f, ang); r = fmaf(-n, 1.9353071795864769e-3f, r);
            const float rev = r * 0.15915494309189535f;
            cosT[idx] = __builtin_amdgcn_cosf(rev); sinT[idx] = __builtin_amdgcn_sinf(rev);
        }
    }
    convert_layer_weights(p, 0, obid(), ogrid(), lds, 3);
    for (int L = 1; L < 4; ++L) convert_layer_weights(p, L, obid(), ogrid(), lds, 1);
    row_phase(nullptr, p.x, nullptr, nullptr, p.norm_gains, (bf16_t*)(ws + OFF_HB), p.wave);
}

enum { EPI_F32 = 0, EPI_ATT_IN = 1, EPI_REC_IN = 2, EPI_FFN_IN = 3 };
constexpr int LDK = 72;

DI int lds_byte(int r, int c) { const int st = (r >> 4) * 2 + (c >> 5), ob = (r & 15) * 64 + (c & 31) * 2; return st * 1024 + (ob ^ (((ob >> 9) & 1) << 5)); }
DI void stage_rc(int b, int& R, int& C) { const int st = b >> 10, sb = b & 1023, swz = sb ^ (((sb >> 9) & 1) << 5); R = (st / 2) * 16 + swz / 64; C = (st % 2) * 32 + (swz % 64) / 2; }

#define LAS3 __attribute__((address_space(3)))
template <int EPI>
DI void gemm_phase(const bf16_t* __restrict__ A, const bf16_t* __restrict__ Bt, const int K, const int N, const Params& p, const int layer_j, char* lds) {
    const int wid = p.wave;
    const int lane = olane(), wr = wid >> 2, wc = wid & 3;
    constexpr int HTB = 128 * 64 * 2, NXCD = 8, WGM = 1, HALF = 128;
    const int nM = M_TOK / 256, nN = N / 256, nwg = nM * nN, nt = K / 64;
    unsigned char* ws = p.ws;
    LAS3 char* L = (LAS3 char*)lds;
    int stoff = (wid * 64 + lane) * 16;
    int aoff = lds_byte(wr * 64 + (lane & 15), (lane >> 4) * 8), boff = lds_byte(wc * 32 + (lane & 15), (lane >> 4) * 8);
    asm volatile("" : "+v"(stoff), "+v"(aoff), "+v"(boff));
#define SA(b, h) (((b) * 2 + (h)) * HTB)
#define SB(b, h) ((4 + (b) * 2 + (h)) * HTB)
#define STAGE(bufoff, GB) do { const char* g_ = (GB); \
        _Pragma("unroll") for (int i_ = 0; i_ < 2; ++i_) __builtin_amdgcn_global_load_lds((const unsigned*)(g_ + voff[i_]), (LAS3 unsigned*)(L + (bufoff) + stoff + i_ * 8192), 16, 0, 0); } while (0)
#define LDA(dst, b, h) do { _Pragma("unroll") for (int m = 0; m < 4; ++m) _Pragma("unroll") for (int k = 0; k < 2; ++k) dst[m][k] = *(const LAS3 bf16x8*)(L + SA(b, h) + aoff + m * 2048 + k * 1024); } while (0)
#define LDB(dst, b, h) do { _Pragma("unroll") for (int n = 0; n < 2; ++n) _Pragma("unroll") for (int k = 0; k < 2; ++k) dst[n][k] = *(const LAS3 bf16x8*)(L + SB(b, h) + boff + n * 2048 + k * 1024); } while (0)
#define MMA(ai, bj, At_, Bt_) do { __builtin_amdgcn_s_setprio(1); _Pragma("unroll") for (int m = 0; m < 4; ++m) _Pragma("unroll") for (int n = 0; n < 2; ++n) _Pragma("unroll") for (int k = 0; k < 2; ++k) \
        acc[ai][bj][m][n] = (EPI == EPI_FFN_IN) ? __builtin_amdgcn_mfma_f32_16x16x32_bf16(Bt_[n][k], At_[m][k], acc[ai][bj][m][n], 0, 0, 0) \
                                                : __builtin_amdgcn_mfma_f32_16x16x32_bf16(At_[m][k], Bt_[n][k], acc[ai][bj][m][n], 0, 0, 0); __builtin_amdgcn_s_setprio(0); } while (0)
#define WAIT_V(n) asm volatile("s_waitcnt vmcnt(" #n ")" ::: "memory")
#define WAIT_L(n) asm volatile("s_waitcnt lgkmcnt(" #n ")" ::: "memory")
#define BAR __builtin_amdgcn_s_barrier()
#define SCHED __builtin_amdgcn_sched_barrier(0)
#define TILE_COORDS(LID, PM, PN) do { int wgid_ = (LID); \
        { const int q_ = nwg / NXCD, r_ = nwg % NXCD, xcd_ = wgid_ % NXCD, off_ = wgid_ / NXCD; wgid_ = (xcd_ < r_ ? xcd_ * (q_ + 1) : r_ * (q_ + 1) + (xcd_ - r_) * q_) + off_; } \
        const int nig_ = WGM * nN, gid_ = wgid_ / nig_, fm_ = gid_ * WGM, gsz_ = (nM - fm_) < WGM ? (nM - fm_) : WGM; \
        PM = fm_ + ((wgid_ % nig_) % gsz_); PN = (wgid_ % nig_) / gsz_; } while (0)
#define VOFF_INIT() do { _Pragma("unroll") for (int i = 0; i < 2; ++i) { int R, C; stage_rc((wid * 64 + olane()) * 16 + i * 8192, R, C); voff[i] = (unsigned)(R * K + C) * 2u; } } while (0)
    if (obid() >= nwg) return;
    int pm, pn;
    TILE_COORDS(obid(), pm, pn);
    const size_t kstep = 128, hstep = (size_t)HALF * K * 2, tstep = 2 * hstep;
    const char* cA = (const char*)A + (size_t)pm * tstep; const char* cB = (const char*)Bt + (size_t)pn * tstep;
    f32x4 acc[2][2][4][2];
#pragma unroll
    for (int a = 0; a < 2; ++a)
#pragma unroll
        for (int b = 0; b < 2; ++b)
#pragma unroll
            for (int m = 0; m < 4; ++m)
#pragma unroll
                for (int n = 0; n < 2; ++n) acc[a][b][m][n] = (f32x4){0.f, 0.f, 0.f, 0.f};
    bf16x8 At[4][2], B0[2][2], B1[2][2];
    {
        unsigned voff[2]; VOFF_INIT();
        asm volatile("s_waitcnt vmcnt(0) lgkmcnt(0)" ::: "memory");
        __syncthreads();
        STAGE(SB(0, 0), cB); STAGE(SB(0, 1), cB + hstep); STAGE(SA(0, 0), cA); STAGE(SA(0, 1), cA + hstep);
        if (wr == 1) BAR;
        WAIT_V(2); BAR;
        STAGE(SB(1, 0), cB + kstep); STAGE(SA(1, 0), cA + kstep); STAGE(SB(1, 1), cB + hstep + kstep);
        WAIT_V(6); BAR;
    }
    for (int ui = 0;; ++ui) {
        const int Lnext = (ui + 1) * ogrid() + obid();
        const bool has_next = Lnext < nwg;
        int pm2 = pm, pn2 = pn;
        if (has_next) TILE_COORDS(Lnext, pm2, pn2);
        const char* nA = (const char*)A + (size_t)pm2 * tstep; const char* nB = (const char*)Bt + (size_t)pn2 * tstep;
        unsigned voff[2]; VOFF_INIT();
        for (int t = 0; t < nt; t += 2) {
            const bool last = (t == nt - 2);
            const char* a1 = cA + (size_t)(t + 1) * kstep;
            const char* a2 = last ? nA : cA + (size_t)(t + 2) * kstep; const char* b2 = last ? nB : cB + (size_t)(t + 2) * kstep;
            const char* a3 = a2 + kstep; const char* b3 = b2 + kstep;
            LDB(B0, 0, 0); LDB(B1, 0, 1); SCHED; LDA(At, 0, 0); STAGE(SA(1, 1), a1 + hstep);
            WAIT_V(8); WAIT_L(0); BAR; MMA(0, 0, At, B0); MMA(0, 1, At, B1); BAR; SCHED;
            LDA(At, 0, 1); STAGE(SB(0, 0), b2); STAGE(SB(0, 1), b2 + hstep); STAGE(SA(0, 0), a2);
            WAIT_V(8); WAIT_L(0); BAR; MMA(1, 0, At, B0); MMA(1, 1, At, B1); BAR; SCHED;
            LDB(B0, 1, 0); LDB(B1, 1, 1); SCHED; LDA(At, 1, 0); STAGE(SA(0, 1), a2 + hstep);
            WAIT_V(8); WAIT_L(0); BAR; MMA(0, 0, At, B0); MMA(0, 1, At, B1); BAR; SCHED;
            LDA(At, 1, 1); STAGE(SB(1, 0), b3); STAGE(SB(1, 1), b3 + hstep); STAGE(SA(1, 0), a3);
            WAIT_V(8); WAIT_L(0); BAR; MMA(1, 0, At, B0); MMA(1, 1, At, B1); BAR; SCHED;
        }
        if (wr == 0) BAR;
        const int le = olane(), fr = le & 15, fq = le >> 4;
        const int row0 = pm * 256 + wr * 64 + fq * 4;
        const int col0 = pn * 256 + wc * 64;
        if (EPI == EPI_F32) {
            bf16_t* T = (bf16_t*)(ws + OFF_T) + (size_t)row0 * DM + col0 + fr;
#pragma unroll
            for (int ai = 0; ai < 2; ++ai)
#pragma unroll
                for (int m = 0; m < 4; ++m)
#pragma unroll
                    for (int j = 0; j < 4; ++j)
#pragma unroll
                        for (int bj = 0; bj < 2; ++bj)
#pragma unroll
                            for (int n = 0; n < 2; ++n) T[(size_t)(ai * 128 + m * 16 + j) * DM + bj * 32 + n * 16] = f2bf(acc[ai][bj][m][n][j]);
        } else if (EPI == EPI_FFN_IN) {
            bf16_t* HID = (bf16_t*)(ws + OFF_P) + (size_t)(pm * 256 + wr * 64 + fr) * FFN_H + (col0 >> 1) + 8 * fq;
#pragma unroll
            for (int ai = 0; ai < 2; ++ai)
#pragma unroll
                for (int m = 0; m < 4; ++m) {
                    u32x4 o;
#pragma unroll
                    for (int n = 0; n < 2; ++n) {
                        o[2 * n] = pk_bf16(silu_f(acc[ai][0][m][n][0]) * acc[ai][1][m][n][0], silu_f(acc[ai][0][m][n][1]) * acc[ai][1][m][n][1]);
                        o[2 * n + 1] = pk_bf16(silu_f(acc[ai][0][m][n][2]) * acc[ai][1][m][n][2], silu_f(acc[ai][0][m][n][3]) * acc[ai][1][m][n][3]); }
                    *(u32x4*)(HID + (size_t)(ai * 128 + m * 16) * FFN_H) = o;
                }
        } else if (EPI == EPI_ATT_IN) {
            bf16_t* PROJ = (bf16_t*)(ws + OFF_P);
            bf16_t* VT = PROJ + (size_t)M_TOK * ATT_IN;
            const int region = col0 >> 9;
            if (region == 2 || region == 5) {
                const int vc0 = (region == 2 ? col0 - 1024 : 512 + col0 - 2560);
                const int b = row0 >> 11, t0 = row0 & 2047;
                bf16_t* dst = VT + ((size_t)(b * 1024 + vc0 + fr)) * SEQ + t0;
#pragma unroll
                for (int bj = 0; bj < 2; ++bj)
#pragma unroll
                    for (int n = 0; n < 2; ++n)
#pragma unroll
                        for (int ai = 0; ai < 2; ++ai)
#pragma unroll
                            for (int m = 0; m < 4; ++m) { u32x2 o; o[0] = pk_bf16(acc[ai][bj][m][n][0], acc[ai][bj][m][n][1]); o[1] = pk_bf16(acc[ai][bj][m][n][2], acc[ai][bj][m][n][3]);
                                *(u32x2*)(dst + (size_t)(bj * 32 + n * 16) * SEQ + ai * 128 + m * 16) = o; }
            } else {
                const float sc = (region == 0 || region == 3) ? 0.125f * LOG2E : 1.0f;
                const float* cb = (const float*)(ws + OFF_ROPE) + (row0 & 2047) * 32 + fr;
                bf16_t* dst = PROJ + (size_t)row0 * ATT_IN + col0 + fr;
#pragma unroll
                for (int ai = 0; ai < 2; ++ai)
#pragma unroll
                    for (int m = 0; m < 4; ++m)
#pragma unroll
                        for (int j = 0; j < 4; ++j)
#pragma unroll
                            for (int n = 0; n < 2; ++n) {
                                const int ro = ai * 128 + m * 16 + j;
                                const float c = cb[ro * 32 + n * 16], sn = cb[2048 * 32 + ro * 32 + n * 16];
                                const float x1 = acc[ai][0][m][n][j], x2 = acc[ai][1][m][n][j];
                                dst[(size_t)ro * ATT_IN + n * 16] = f2bf((x1 * c - x2 * sn) * sc); dst[(size_t)ro * ATT_IN + 32 + n * 16] = f2bf((x2 * c + x1 * sn) * sc);
                                if (n == 1 && (j & 1)) __builtin_amdgcn_sched_barrier(0); }
            }
        } else if (EPI == EPI_REC_IN) {
            bf16_t* PROJ = (bf16_t*)(ws + OFF_P);
            bf16_t* IT = PROJ + (size_t)M_TOK * ATT_IN;
            const int region = col0 >> 10;
            if (region == 2) {
                const int vc0 = col0 - 2048;
                const int b = row0 >> 11, t0 = row0 & 2047;
                bf16_t* dst = IT + ((size_t)(b * 1024 + vc0 + fr)) * SEQ + t0;
#pragma unroll
                for (int bj = 0; bj < 2; ++bj)
#pragma unroll
                    for (int n = 0; n < 2; ++n)
#pragma unroll
                        for (int ai = 0; ai < 2; ++ai)
#pragma unroll
                            for (int m = 0; m < 4; ++m) { u32x2 o; o[0] = pk_bf16(acc[ai][bj][m][n][0], acc[ai][bj][m][n][1]); o[1] = pk_bf16(acc[ai][bj][m][n][2], acc[ai][bj][m][n][3]);
                                *(u32x2*)(dst + (size_t)(bj * 32 + n * 16) * SEQ + ai * 128 + m * 16) = o; }
            } else if (region == 1) {
                float* lf = (float*)(ws + OFF_T) + (size_t)row0 * DM + (col0 - 1024) + fr;
                bf16_t* dst = PROJ + (size_t)row0 * ATT_IN + col0 + fr;
#pragma unroll
                for (int bj = 0; bj < 2; ++bj)
#pragma unroll
                    for (int n = 0; n < 2; ++n) {
                        float lb = 0.f;
                        if (layer_j == 1) { const float a0 = p.rec_lb[col0 - 1024 + bj * 32 + n * 16 + fr], a1 = p.rec_lb[DM + col0 - 1024 + bj * 32 + n * 16 + fr]; lb = 1.f / (1.f + __expf(a0 - a1)); }
#pragma unroll
                        for (int ai = 0; ai < 2; ++ai)
#pragma unroll
                            for (int m = 0; m < 4; ++m)
#pragma unroll
                                for (int j = 0; j < 4; ++j) {
                                    const float sg = __builtin_amdgcn_rcpf(1.f + __expf(-acc[ai][bj][m][n][j])); const float fg = lb + (1.f - lb) * sg;
                                    lf[(size_t)(ai * 128 + m * 16 + j) * DM + bj * 32 + n * 16] = __logf(fg);
                                    dst[(size_t)(ai * 128 + m * 16 + j) * ATT_IN + bj * 32 + n * 16] = f2bf(1.f - fg);
                                    if (j == 3) __builtin_amdgcn_sched_barrier(0); } }
            } else {
                const int dc0 = (region == 0) ? col0 : (col0 - 3072 + 2048);
                const float sc = (region == 0) ? 0.08838834764831845f : 1.0f;
                bf16_t* dst = PROJ + (size_t)row0 * ATT_IN + dc0 + fr;
#pragma unroll
                for (int ai = 0; ai < 2; ++ai)
#pragma unroll
                    for (int m = 0; m < 4; ++m)
#pragma unroll
                        for (int j = 0; j < 4; ++j)
#pragma unroll
                            for (int bj = 0; bj < 2; ++bj)
#pragma unroll
                                for (int n = 0; n < 2; ++n) dst[(size_t)(ai * 128 + m * 16 + j) * ATT_IN + bj * 32 + n * 16] = f2bf(silu_f(acc[ai][bj][m][n][j]) * sc);
            }
        }
        if (!has_next) break;
#pragma unroll
        for (int a = 0; a < 2; ++a)
#pragma unroll
            for (int b = 0; b < 2; ++b)
#pragma unroll
                for (int m = 0; m < 4; ++m)
#pragma unroll
                    for (int n = 0; n < 2; ++n) acc[a][b][m][n] = (f32x4){0.f, 0.f, 0.f, 0.f};
        pm = pm2; pn = pn2; cA = nA; cB = nB;
        if (wr == 1) BAR;
    }
    WAIT_V(0);
    BAR;
#undef TILE_COORDS
#undef VOFF_INIT
#undef SA
#undef SB
#undef STAGE
#undef LDA
#undef LDB
#undef MMA
}

template <int DV, bool MULT>
DI void attn_pass(const bf16_t* __restrict__ Kg, const bf16_t* __restrict__ VTg, const bf16x8 (&qf)[4], const int q0, f32x16 (&O)[DV / 32], float& m_run, float& l_run, char* lds, const int gw) {
    const int tid = otid_w(gw), lane = tid & 63, w = tid >> 6, l31 = lane & 31, hh = lane >> 5;
    constexpr int LDV = 136;
    bf16_t* Ks = (bf16_t*)lds;
    bf16_t* Vs = Ks + 128 * LDK;
    constexpr int NV = DV / 32;
    const int nkt = (q0 + 256) / 128;
    const int qpos = q0 + w * 32 + l31;
    const int qhi = q0 + w * 32 + 31, q0w = q0 + w * 32;
    float adjF[16], adjM[16];
    if (MULT) {
#pragma unroll
        for (int i = 0; i < 16; ++i) { const int d = (l31 - crow(i, hh)) & 15; adjF[i] = (d == 0) ? 0.f : -1e30f; adjM[i] = ((d & 3) == 0) ? ((d == 0) ? 1.f : 0.f) : -1e30f; }
    }
    u32x4 rk[2], rv[NV];
#pragma unroll
    for (int i = 0; i < 2; ++i) { const int c = tid + 512 * i, key = c >> 3, d8 = c & 7; rk[i] = *(const u32x4*)(Kg + (size_t)key * ATT_IN + d8 * 8); }
#pragma unroll
    for (int i = 0; i < NV; ++i) { const int c = tid + 512 * i, dv = c >> 4, k8 = c & 15; rv[i] = *(const u32x4*)(VTg + (size_t)dv * SEQ + k8 * 8); }
    for (int kt = 0; kt < nkt; ++kt) {
        const int kb0 = kt * 128;
        __syncthreads();
#pragma unroll
        for (int i = 0; i < 2; ++i) { const int c = tid + 512 * i, key = c >> 3, d8 = c & 7; *(u32x4*)(Ks + key * LDK + d8 * 8) = rk[i]; }
#pragma unroll
        for (int i = 0; i < NV; ++i) { const int c = tid + 512 * i, dv = c >> 4, k8 = c & 15; u32x2 lo_, hi_; lo_[0] = rv[i][0]; lo_[1] = rv[i][1]; hi_[0] = rv[i][2]; hi_[1] = rv[i][3];
            { const int g16 = (k8 >> 1) * 16, cc = k8 & 1; *(u32x2*)(Vs + dv * LDV + g16 + 4 * cc) = lo_; *(u32x2*)(Vs + dv * LDV + g16 + 8 + 4 * cc) = hi_; } }
        __syncthreads();
        if (kt + 1 < nkt) {
#pragma unroll
            for (int i = 0; i < 2; ++i) { const int c = tid + 512 * i, key = c >> 3, d8 = c & 7; rk[i] = *(const u32x4*)(Kg + (size_t)(kb0 + 128 + key) * ATT_IN + d8 * 8); }
#pragma unroll
            for (int i = 0; i < NV; ++i) { const int c = tid + 512 * i, dv = c >> 4, k8 = c & 15; rv[i] = *(const u32x4*)(VTg + (size_t)dv * SEQ + kb0 + 128 + k8 * 8); }
        }
#pragma unroll 1
        for (int hf = 0; hf < 2; ++hf) {
        const int kb = kb0 + hf * 64;
        const bf16_t* Kh = Ks + hf * 64 * LDK;
        const bf16_t* Vh = Vs + hf * 64;
        if (kb <= qhi) {
            f32x16 st[2];
#pragma unroll
            for (int k2 = 0; k2 < 2; ++k2) {
#pragma unroll
                for (int i = 0; i < 16; ++i) st[k2][i] = 0.f;
#pragma unroll
                for (int ks = 0; ks < 4; ++ks) { const bf16x8 a = *(const bf16x8*)(Kh + (32 * k2 + l31) * LDK + ks * 16 + 8 * hh); st[k2] = MFMA32(a, qf[ks], st[k2]); }
            }
            float mx = -1e30f;
            const bool zfar = MULT && (kb + 63 + 512 < q0w);
            const bool zmid = MULT && !zfar && (q0w - (kb + 63) > 128) && (q0w + 31 - kb <= 512);
            const bool zfree = !MULT && (kb + 63 <= q0w);
            if (zfar) {
#pragma unroll
                for (int k2 = 0; k2 < 2; ++k2)
#pragma unroll
                    for (int i = 0; i < 16; ++i) { const float sv = st[k2][i] + adjF[i]; st[k2][i] = sv; mx = fmaxf(mx, sv); }
            } else if (zmid) {
#pragma unroll
                for (int k2 = 0; k2 < 2; ++k2)
#pragma unroll
                    for (int i = 0; i < 16; ++i) { const float sv = st[k2][i] + adjM[i]; st[k2][i] = sv; mx = fmaxf(mx, sv); }
            } else if (zfree) {
#pragma unroll
                for (int k2 = 0; k2 < 2; ++k2)
#pragma unroll
                    for (int i = 0; i < 16; ++i) mx = fmaxf(mx, st[k2][i]);
            } else {
#pragma unroll
                for (int k2 = 0; k2 < 2; ++k2)
#pragma unroll
                    for (int i = 0; i < 16; ++i) {
                        const int key = kb + 32 * k2 + crow(i, hh); const int dl = qpos - key;
                        float sv;
                        if (MULT) {
                            const int c = (dl >= 0) ? ((dl <= 128 ? 1 : 0) + (((dl & 3) == 0 && dl <= 512) ? 1 : 0) + (((dl & 15) == 0) ? 1 : 0)) : 0;
                            const float adj = (c == 3) ? 1.5849625007211562f : ((c == 2) ? 1.0f : 0.0f);
                            sv = (c > 0) ? st[k2][i] + adj : -1e30f;
                        } else {
                            sv = (dl >= 0) ? st[k2][i] : -1e30f;
                        }
                        st[k2][i] = sv; mx = fmaxf(mx, sv);
                    }
            }
            mx = fmaxf(mx, shx(mx, 32));
            const float m_new = fmaxf(m_run, mx);
            if (__builtin_amdgcn_ballot_w64(m_new > m_run + 8.0f) != 0ull) {
                const float alpha = __builtin_amdgcn_exp2f(m_run - m_new);
                m_run = m_new; l_run *= alpha;
#pragma unroll
                for (int dt = 0; dt < DV / 32; ++dt)
#pragma unroll
                    for (int i = 0; i < 16; ++i) O[dt][i] *= alpha;
            }
            float ps = 0.f;
#pragma unroll
            for (int k2 = 0; k2 < 2; ++k2)
#pragma unroll
                for (int i = 0; i < 16; ++i) { const float pe = __builtin_amdgcn_exp2f(st[k2][i] - m_run); st[k2][i] = pe; ps += pe; }
            l_run += ps;
#pragma unroll
            for (int ks2 = 0; ks2 < 4; ++ks2) {
                const bf16x8 pb = pack8(st[ks2 >> 1], ks2 & 1);
#pragma unroll
                for (int dt = 0; dt < DV / 32; ++dt) {
                    const bf16x8 a = *(const bf16x8*)(Vh + (32 * dt + l31) * LDV + 16 * ks2 + 8 * hh);
                    O[dt] = MFMA32(a, pb, O[dt]);
                }
            }
        }
        }
    }
}

DI void attn_phase(const Params& p, const int j, char* lds, const int cidx) {
    unsigned char* ws = p.ws;
    const bf16_t* PROJ = (const bf16_t*)(ws + OFF_P);
    const bf16_t* VT = PROJ + (size_t)M_TOK * ATT_IN;
    bf16_t* MIX = (bf16_t*)(ws + OFF_HB);
    unsigned* counter = (unsigned*)(ws + OFF_CTRL) + cidx;
    int* s_item = (int*)(lds + LDS_BYTES - 16);
    const int tid = otid_w(p.wave), lane = tid & 63, w = tid >> 6, l31 = lane & 31, hh = lane >> 5;
    const float lambda_init = (j == 0) ? 0.2f : 0.4707130183435842f;
    float lam;
    {
        const float* lp = p.att_lambda + (size_t)j * 4 * 64;
        const float sa = wave_sum(lp[lane] * lp[64 + lane]), sb = wave_sum(lp[128 + lane] * lp[192 + lane]);
        lam = uni(__expf(sa) - __expf(sb) + lambda_init);
    }
    const float* subln = p.att_subln + (size_t)j * 128;
    for (;;) {
        if (tid == 0) *s_item = (int)atomicAdd(counter, 1u);
        __syncthreads();
        const int item = *s_item;
        __syncthreads();
        if (item >= 768) break;
        if (item < 256) {
            const int qt = 7 - (item >> 5), r = item & 31, b = r >> 2, h = r & 3;
            const int q0 = qt * 256;
            const size_t tokq = (size_t)(b * SEQ + q0 + w * 32 + l31);
            unsigned* O0s = (unsigned*)(lds + 53248) + tid;
#pragma unroll
            for (int sub = 0; sub < 2; ++sub) {
                bf16x8 qf[4];
#pragma unroll
                for (int ks = 0; ks < 4; ++ks) qf[ks] = *(const bf16x8*)(PROJ + tokq * ATT_IN + 1536 + (2 * h + sub) * 64 + ks * 16 + 8 * hh);
                f32x16 O[4];
#pragma unroll
                for (int dt = 0; dt < 4; ++dt)
#pragma unroll
                    for (int i = 0; i < 16; ++i) O[dt][i] = 0.f;
                float m_run = -1e29f, l_run = 0.f;
                attn_pass<128, false>(PROJ + (size_t)(b * SEQ) * ATT_IN + 2048 + (2 * h + sub) * 64, VT + (size_t)(b * 1024 + 512 + h * 128) * SEQ, qf, q0, O, m_run, l_run, lds, p.wave);
                const float lt = l_run + shx(l_run, 32);
                const float inv = 1.f / lt;
                if (sub == 0) {
#pragma unroll
                    for (int dt = 0; dt < 4; ++dt)
#pragma unroll
                        for (int i = 0; i < 8; ++i) O0s[(dt * 8 + i) * 512] = pk_bf16(O[dt][2 * i] * inv, O[dt][2 * i + 1] * inv);
                } else {
                    float ss = 0.f;
#pragma unroll
                    for (int dt = 0; dt < 4; ++dt)
#pragma unroll
                        for (int i = 0; i < 8; ++i) { const unsigned pw = O0s[(dt * 8 + i) * 512];
                            const float v0 = __uint_as_float(pw << 16) - lam * O[dt][2 * i] * inv, v1 = __uint_as_float(pw & 0xffff0000u) - lam * O[dt][2 * i + 1] * inv;
                            O[dt][2 * i] = v0; O[dt][2 * i + 1] = v1; ss += v0 * v0 + v1 * v1; }
                    ss += shx(ss, 32);
                    const float rs = rsqrtf(ss * (1.f / 128.f) + EPS) * (1.f - lambda_init);
                    bf16_t* dst = MIX + tokq * DM + 512 + h * 128;
#pragma unroll
                    for (int dt = 0; dt < 4; ++dt)
#pragma unroll
                        for (int g = 0; g < 4; ++g) { const int dv = 32 * dt + 8 * g + 4 * hh; const f32x4 gn = *(const f32x4*)(subln + dv);
                            u32x2 o; o[0] = pk_bf16(O[dt][4 * g] * rs * gn[0], O[dt][4 * g + 1] * rs * gn[1]); o[1] = pk_bf16(O[dt][4 * g + 2] * rs * gn[2], O[dt][4 * g + 3] * rs * gn[3]);
                            *(u32x2*)(dst + dv) = o; }
                }
            }
        } else {
            const int jj = item - 256;
            const int qt = 7 - (jj >> 6), r = jj & 63, b = r >> 3, h = r & 7;
            const int q0 = qt * 256;
            const size_t tokq = (size_t)(b * SEQ + q0 + w * 32 + l31);
            bf16x8 qf[4];
#pragma unroll
            for (int ks = 0; ks < 4; ++ks) qf[ks] = *(const bf16x8*)(PROJ + tokq * ATT_IN + h * 64 + ks * 16 + 8 * hh);
            f32x16 O[2];
#pragma unroll
            for (int dt = 0; dt < 2; ++dt)
#pragma unroll
                for (int i = 0; i < 16; ++i) O[dt][i] = 0.f;
            float m_run = -1e29f, l_run = 0.f;
            attn_pass<64, true>(PROJ + (size_t)(b * SEQ) * ATT_IN + 512 + h * 64, VT + (size_t)(b * 1024 + h * 64) * SEQ, qf, q0, O, m_run, l_run, lds, p.wave);
            const float lt = l_run + shx(l_run, 32);
            const float inv = 1.f / lt;
            bf16_t* dst = MIX + tokq * DM + h * 64;
#pragma unroll
            for (int dt = 0; dt < 2; ++dt)
#pragma unroll
                for (int g = 0; g < 4; ++g) { const int dv = 32 * dt + 8 * g + 4 * hh;
                    u32x2 o; o[0] = pk_bf16(O[dt][4 * g] * inv, O[dt][4 * g + 1] * inv); o[1] = pk_bf16(O[dt][4 * g + 2] * inv, O[dt][4 * g + 3] * inv);
                    *(u32x2*)(dst + dv) = o; }
        }
    }
}

template <bool FULL>
DI void hgrn_pass(const Params& p, const int j, char* lds) {
    unsigned char* ws = p.ws;
    const bf16_t* PROJ = (const bf16_t*)(ws + OFF_P);
    const bf16_t* IT = PROJ + (size_t)M_TOK * ATT_IN;
    const float* LOGF = (const float*)(ws + OFF_T);
    bf16_t* UB = (bf16_t*)(ws + OFF_U);
    float* DB = (float*)(ws + OFF_D);
    bf16_t* MIX = (bf16_t*)(ws + OFF_HB);
    const float* ggain = p.rec_gnorm + (size_t)j * 128;
    const int tid512 = otid_w(p.wave), grp = tid512 >> 8, tid = tid512 & 255, lane = tid & 63, w = tid >> 6, l31 = lane & 31, hh = lane >> 5;
    constexpr int LQ = 136, LV = 40, LO = 132;
    float* tot = (float*)(lds + grp * 57344);
    float* dvec = tot + 256;
    float* Bc = dvec + 128;
    float* Ot = Bc;
    bf16_t* Qh = (bf16_t*)(Bc + 32 * LO);
    bf16_t* Kt = Qh + 32 * LQ;
    bf16_t* KhT = Kt + 32 * LQ;
    bf16_t* VTs = KhT + 128 * LV;
    const int kk = tid & 127, half = tid >> 7;
    for (int item0 = obid() * 2; item0 < 512; item0 += ogrid() * 2) {
        const int item = item0 + grp, bh = item >> 3, seg = item & 7, b = bh >> 3, h = bh & 7;
        f32x16 S[4];
#pragma unroll
        for (int kt = 0; kt < 4; ++kt)
#pragma unroll
            for (int i = 0; i < 16; ++i) S[kt][i] = 0.f;
        if (FULL) {
            for (int i = 0; i < seg; ++i) {
                const bf16_t* U = UB + ((size_t)(bh * 8 + i) * 4 + w) * 4096 + lane * 16;
                const float* D = DB + (size_t)(bh * 8 + i) * 128;
#pragma unroll
                for (int kt = 0; kt < 4; ++kt) {
                    const u32x4 u0 = *(const u32x4*)(U + kt * 1024), u1 = *(const u32x4*)(U + kt * 1024 + 8);
#pragma unroll
                    for (int g = 0; g < 4; ++g) { const f32x4 dv = *(const f32x4*)(D + 32 * kt + 8 * g + 4 * hh);
                        const unsigned w0 = (g < 2) ? u0[2 * g] : u1[2 * (g - 2)], w1 = (g < 2) ? u0[2 * g + 1] : u1[2 * (g - 2) + 1];
                        S[kt][4 * g + 0] = S[kt][4 * g + 0] * dv[0] + __uint_as_float(w0 << 16);
                        S[kt][4 * g + 1] = S[kt][4 * g + 1] * dv[1] + __uint_as_float(w0 & 0xffff0000u);
                        S[kt][4 * g + 2] = S[kt][4 * g + 2] * dv[2] + __uint_as_float(w1 << 16);
                        S[kt][4 * g + 3] = S[kt][4 * g + 3] * dv[3] + __uint_as_float(w1 & 0xffff0000u); }
                }
            }
        }
        const size_t rowS = (size_t)b * SEQ + seg * 256;
        float segsum = 0.f;
        float lf[16]; u32x4 kq[2], qq[2], vv[2];
#define H_LOADS(c) do { const size_t r0_ = rowS + (c) * 32; \
            _Pragma("unroll") for (int t = 0; t < 16; ++t) lf[t] = LOGF[(r0_ + 16 * half + t) * DM + h * 128 + kk]; \
            _Pragma("unroll") for (int i = 0; i < 2; ++i) { const int ci = tid + 256 * i, t = ci >> 4, k8 = (ci & 15) * 8; \
                kq[i] = *(const u32x4*)(PROJ + (r0_ + t) * ATT_IN + 1024 + h * 128 + k8); if (FULL) qq[i] = *(const u32x4*)(PROJ + (r0_ + t) * ATT_IN + h * 128 + k8); } \
            _Pragma("unroll") for (int i = 0; i < 2; ++i) { const int ci = tid + 256 * i, v = ci >> 2, s8 = (ci & 3) * 8; \
                vv[i] = *(const u32x4*)(IT + (size_t)(b * 1024 + h * 128 + v) * SEQ + seg * 256 + (c) * 32 + s8); } } while (0)
        H_LOADS(0);
        for (int c = 0; c < 8; ++c) {
            const size_t row0 = rowS + c * 32;
            float bc[16];
            {
                float run = 0.f;
#pragma unroll
                for (int t = 0; t < 16; ++t) { run += lf[t]; bc[t] = run; }
                tot[half * 128 + kk] = run;
            }
            __syncthreads();
            {
                const float t0v = tot[kk], t1v = tot[128 + kk];
                const float blast = t0v + t1v;
                const float add = half ? t0v : 0.f;
                if (half == 0) { dvec[kk] = __expf(blast); segsum += blast; }
#pragma unroll
                for (int t = 0; t < 16; ++t) Bc[(16 * half + t) * LO + kk] = bc[t] + add;
            }
            __syncthreads();
#pragma unroll
            for (int i = 0; i < 2; ++i) {
                const int ci = tid + 256 * i, t = ci >> 4, k8 = (ci & 15) * 8;
                const f32x4 b0 = *(const f32x4*)(Bc + t * LO + k8), b1 = *(const f32x4*)(Bc + t * LO + k8 + 4);
                const f32x4 ta = *(const f32x4*)(tot + k8), tb = *(const f32x4*)(tot + k8 + 4), tc = *(const f32x4*)(tot + 128 + k8), td = *(const f32x4*)(tot + 128 + k8 + 4);
                float bcv[8], blv[8], kf[8], qf[8];
#pragma unroll
                for (int e = 0; e < 4; ++e) { bcv[e] = b0[e]; bcv[4 + e] = b1[e]; blv[e] = ta[e] + tc[e]; blv[4 + e] = tb[e] + td[e]; }
#pragma unroll
                for (int e = 0; e < 4; ++e) { kf[2 * e] = __uint_as_float(kq[i][e] << 16); kf[2 * e + 1] = __uint_as_float(kq[i][e] & 0xffff0000u); }
#pragma unroll
                for (int e = 0; e < 8; ++e) KhT[(k8 + (e ^ ((k8 >> 3) & 7))) * LV + t] = f2bf(kf[e] * __expf(blv[e] - bcv[e]));
                if (FULL) {
#pragma unroll
                    for (int e = 0; e < 4; ++e) { qf[2 * e] = __uint_as_float(qq[i][e] << 16); qf[2 * e + 1] = __uint_as_float(qq[i][e] & 0xffff0000u); }
                    u32x4 oq, ok;
#pragma unroll
                    for (int e = 0; e < 4; ++e) {
                        oq[e] = pk_bf16(qf[2 * e] * __expf(bcv[2 * e]), qf[2 * e + 1] * __expf(bcv[2 * e + 1]));
                        ok[e] = pk_bf16(kf[2 * e] * __expf(-bcv[2 * e]), kf[2 * e + 1] * __expf(-bcv[2 * e + 1])); }
                    *(u32x4*)(Qh + t * LQ + k8) = oq; *(u32x4*)(Kt + t * LQ + k8) = ok;
                }
            }
#pragma unroll
            for (int i = 0; i < 2; ++i) { const int ci = tid + 256 * i, v = ci >> 2, s8 = (ci & 3) * 8; *(u32x4*)(VTs + v * LV + s8) = vv[i]; }
            u32x4 gg0, gg1;
            if (FULL) { const int t = tid >> 3, sg = tid & 7; const bf16_t* gp = PROJ + (row0 + t) * ATT_IN + 2048 + h * 128 + sg * 16; gg0 = *(const u32x4*)gp; gg1 = *(const u32x4*)(gp + 8); }
            if (c + 1 < 8) H_LOADS(c + 1);
            __syncthreads();
            f32x16 o;
            if (FULL) {
                f32x16 at;
#pragma unroll
                for (int i = 0; i < 16; ++i) at[i] = 0.f;
#pragma unroll
                for (int ks = 0; ks < 8; ++ks) { const bf16x8 a = *(const bf16x8*)(Kt + l31 * LQ + ks * 16 + 8 * hh); const bf16x8 bq = *(const bf16x8*)(Qh + l31 * LQ + ks * 16 + 8 * hh); at = MFMA32(a, bq, at); }
#pragma unroll
                for (int i = 0; i < 16; ++i) at[i] = (crow(i, hh) <= l31) ? at[i] : 0.f;
#pragma unroll
                for (int i = 0; i < 16; ++i) o[i] = 0.f;
#pragma unroll
                for (int kt = 0; kt < 4; ++kt)
#pragma unroll
                    for (int s2 = 0; s2 < 2; ++s2) { const bf16_t* qp = Qh + l31 * LQ + 32 * kt + 16 * s2 + 4 * hh; const bf16x8 aq = ld_b64x2(qp, qp + 8); const bf16x8 bs = pack8(S[kt], s2); o = MFMA32(aq, bs, o); }
#pragma unroll
                for (int s2 = 0; s2 < 2; ++s2) { const bf16_t* vp = VTs + (32 * w + l31) * LV + 16 * s2 + 4 * hh; const bf16x8 bv = ld_b64x2(vp, vp + 8); const bf16x8 pa = pack8(at, s2); o = MFMA32(pa, bv, o); }
            }
#pragma unroll
            for (int kt = 0; kt < 4; ++kt) {
#pragma unroll
                for (int g = 0; g < 4; ++g) { const f32x4 dv = *(const f32x4*)(dvec + 32 * kt + 8 * g + 4 * hh);
                    S[kt][4 * g] *= dv[0]; S[kt][4 * g + 1] *= dv[1]; S[kt][4 * g + 2] *= dv[2]; S[kt][4 * g + 3] *= dv[3]; }
#pragma unroll
                for (int s2 = 0; s2 < 2; ++s2) { const int kr_ = 32 * kt + l31; const bf16x8 a = *(const bf16x8*)(KhT + (kr_ ^ ((kr_ >> 3) & 7)) * LV + 16 * s2 + 8 * hh); const bf16x8 bv = *(const bf16x8*)(VTs + (32 * w + l31) * LV + 16 * s2 + 8 * hh); S[kt] = MFMA32(a, bv, S[kt]); }
            }
            if (FULL) {
#pragma unroll
                for (int i = 0; i < 16; ++i) Ot[crow(i, hh) * LO + 32 * w + l31] = o[i];
                __syncthreads();
                const int t = tid >> 3, sg = tid & 7;
                f32x4 ov[4]; float ss = 0.f;
#pragma unroll
                for (int q = 0; q < 4; ++q) { ov[q] = *(const f32x4*)(Ot + t * LO + sg * 16 + 4 * q); ss += ov[q][0] * ov[q][0] + ov[q][1] * ov[q][1] + ov[q][2] * ov[q][2] + ov[q][3] * ov[q][3]; }
                ss += shx(ss, 1); ss += shx(ss, 2); ss += shx(ss, 4);
                const float rs = rsqrtf(ss * (1.f / 128.f) + EPS);
                float gt[16];
#pragma unroll
                for (int e = 0; e < 4; ++e) { gt[2 * e] = __uint_as_float(gg0[e] << 16); gt[2 * e + 1] = __uint_as_float(gg0[e] & 0xffff0000u);
                    gt[8 + 2 * e] = __uint_as_float(gg1[e] << 16); gt[8 + 2 * e + 1] = __uint_as_float(gg1[e] & 0xffff0000u); }
                float res[16];
#pragma unroll
                for (int q = 0; q < 4; ++q) { const f32x4 gn = *(const f32x4*)(ggain + sg * 16 + 4 * q);
#pragma unroll
                    for (int e = 0; e < 4; ++e) res[4 * q + e] = ov[q][e] * rs * gn[e] * gt[4 * q + e]; }
                u32x4 o0, o1;
#pragma unroll
                for (int e = 0; e < 4; ++e) { o0[e] = pk_bf16(res[2 * e], res[2 * e + 1]); o1[e] = pk_bf16(res[8 + 2 * e], res[8 + 2 * e + 1]); }
                bf16_t* dst = MIX + (row0 + t) * DM + h * 128 + sg * 16;
                *(u32x4*)dst = o0; *(u32x4*)(dst + 8) = o1;
            }
        }
#undef H_LOADS
        if (!FULL) {
            bf16_t* U = UB + ((size_t)item * 4 + w) * 4096 + lane * 16;
#pragma unroll
            for (int kt = 0; kt < 4; ++kt) {
                u32x4 u0, u1;
#pragma unroll
                for (int e = 0; e < 4; ++e) { u0[e] = pk_bf16(S[kt][2 * e], S[kt][2 * e + 1]); u1[e] = pk_bf16(S[kt][8 + 2 * e], S[kt][8 + 2 * e + 1]); }
                *(u32x4*)(U + kt * 1024) = u0; *(u32x4*)(U + kt * 1024 + 8) = u1;
            }
            if (half == 0) DB[(size_t)item * 128 + kk] = __expf(segsum);
        }
        __syncthreads();
    }
}

#define XB_TMO      128
#define XB_XCNT(j)  (256  + 64 * (j))
#define XB_XSUB(j)  (1280 + 64 * (j))
#define XB_XGEN(j)  (2304 + 64 * (j))
#define XB_TOP      3328
#define XB_TOPGEN   3392
#define XCD_BAR_WORDS 3456
#define XB_SPIN_CAP (1u << 18)
#define LAS __attribute__((address_space(3)))
DI unsigned xb_ld(unsigned* p)              { return __hip_atomic_load(p, __ATOMIC_RELAXED, __HIP_MEMORY_SCOPE_AGENT); }
DI unsigned xb_add(unsigned* p, unsigned v) { return __hip_atomic_fetch_add(p, v, __ATOMIC_RELAXED, __HIP_MEMORY_SCOPE_AGENT); }
DI unsigned xb_xcc_id() { return (unsigned)__builtin_amdgcn_s_getreg((3 << 11) | 20) & 0xFu; }
#define XB_SPIN(cond, bar) do { unsigned _sp = 0; while (cond) { __builtin_amdgcn_s_sleep(1); \
    if ((++_sp & 255u) == 0u) { if (xb_ld(&(bar)[XB_TMO])) break; if (_sp > XB_SPIN_CAP) { atomicAdd(&(bar)[XB_TMO], 1u); break; } } } } while (0)
struct XcdBarrier { unsigned* bar; unsigned x; volatile LAS unsigned* st; };
DI XcdBarrier xcd_barrier_post(unsigned* bar, volatile LAS unsigned* st, const int gw) {
    XcdBarrier b; b.bar = bar; b.x = xb_xcc_id(); b.st = st;
    if (gw == 0 && olane() == 0) (void)xb_add(&bar[XB_XCNT(b.x)], 1u);
    return b;
}
DI void xcd_barrier_complete(unsigned* bar, unsigned x, unsigned& nloc, unsigned& nx) {
    const unsigned G = gridDim.x * gridDim.y * gridDim.z;
    unsigned sum, cnt, mine, sp = 0u;
    for (;;) {
        sum = 0u; cnt = 0u; mine = 0u;
#pragma unroll
        for (unsigned j = 0; j < 16; ++j) { const unsigned c = xb_ld(&bar[XB_XCNT(j)]); sum += c; cnt += (c > 0u) ? 1u : 0u; mine = (j == x) ? c : mine; }
        if (sum == G) break;
        __builtin_amdgcn_s_sleep(1);
        if ((++sp & 255u) == 0u) { if (xb_ld(&bar[XB_TMO])) break; if (sp > XB_SPIN_CAP) { atomicAdd(&bar[XB_TMO], 1u); break; } }
    }
    nloc = mine > 0u ? mine : 1u; nx = cnt > 0u ? cnt : 1u;
}
DI void xcd_barrier(const XcdBarrier& b, const int gw) {
    asm volatile("s_waitcnt vmcnt(0)" ::: "memory");
    __syncthreads();
    if (gw == 0 && olane() == 0) {
        unsigned* bar = b.bar;
        __builtin_amdgcn_s_waitcnt(0);
        unsigned nloc = b.st[0], nx = b.st[1];
        if (nloc == 0u) { xcd_barrier_complete(bar, b.x, nloc, nx); b.st[0] = nloc; b.st[1] = nx; }
        const unsigned old = xb_add(&bar[XB_XSUB(b.x)], 1u);
        const unsigned gen = old / nloc;
        if (old + 1u == (gen + 1u) * nloc) {
            __builtin_amdgcn_fence(__ATOMIC_RELEASE, "agent");
            asm volatile("s_waitcnt vmcnt(0)" ::: "memory");
            const unsigned og = xb_add(&bar[XB_TOP], 1u);
            const unsigned tg = og / nx;
            if (og + 1u == (tg + 1u) * nx) xb_add(&bar[XB_TOPGEN], 1u);
            else XB_SPIN(xb_ld(&bar[XB_TOPGEN]) == tg, bar);
            __builtin_amdgcn_fence(__ATOMIC_ACQUIRE, "agent");
            xb_add(&bar[XB_XGEN(b.x)], 1u);
            asm volatile("s_waitcnt vmcnt(0)" ::: "memory");
        } else {
            XB_SPIN(xb_ld(&bar[XB_XGEN(b.x)]) == gen, bar);
            __builtin_amdgcn_fence(__ATOMIC_ACQUIRE, "agent");
            asm volatile("s_waitcnt vmcnt(0)" ::: "memory");
        }
    }
    __syncthreads();
}

#ifndef PROBE_DUP
#define PROBE_DUP 0
#endif
#if PROBE_DUP == 1
constexpr int NST = 11; constexpr unsigned long long SEQ64 = 0x65544322100ull; constexpr int NPRE = 1;
#elif PROBE_DUP == 2
constexpr int NST = 8; constexpr unsigned long long SEQ64 = 0x65432110ull; constexpr int NPRE = 1;
#elif PROBE_DUP == 8
constexpr int NST = 7; constexpr unsigned long long SEQ64 = 0x6543210ull; constexpr int NPRE = 2;
#else
constexpr int NST = 7; constexpr unsigned long long SEQ64 = 0x6543210ull; constexpr int NPRE = 1;
#endif
constexpr int NPH = NPRE + 4 * NST;
__global__ void __launch_bounds__(NTHREADS) fwd_kernel(Params p) {
    __shared__ __attribute__((aligned(16))) char lds[LDS_BYTES];
    cg::grid_group grid = cg::this_grid();
    __shared__ __attribute__((aligned(16))) unsigned xb_words[4];
    if (threadIdx.x < 4) xb_words[threadIdx.x] = 0u;
    __syncthreads();
    const int g_wave = __builtin_amdgcn_readfirstlane((int)(threadIdx.x >> 6));
    (void)xcd_barrier_post((unsigned*)(p.ws + OFF_BAR), (volatile LAS unsigned*)&xb_words, g_wave);
#define XBAR() do { XcdBarrier xb_; xb_.bar = (unsigned*)(p.ws + OFF_BAR); xb_.x = xb_xcc_id(); xb_.st = (volatile LAS unsigned*)&xb_words; xcd_barrier(xb_, g_wave); } while (0)
    for (int ph = p.ph_lo; ph < p.ph_hi; ++ph) {
        Params q = p; q.wave = g_wave;
        asm volatile("" : "+s"(q.ws), "+s"(q.out), "+s"(q.x), "+s"(q.norm_gains));
        unsigned char* ws = q.ws;
        if (ph < NPRE) {
            prep_phase(q, lds);
        } else {
            const int L = (ph - NPRE) / NST, st = (int)((SEQ64 >> (4 * ((ph - NPRE) % NST))) & 15ull), j = L >> 1;
            const float* gains = q.norm_gains + (size_t)L * 4 * DM;
            const bf16_t* HB = (const bf16_t*)(ws + OFF_HB);
            switch (st) {
            case 0:
                if ((L & 1) == 0) gemm_phase<EPI_ATT_IN>(HB, (const bf16_t*)(ws + OFF_ATT_IN_T) + (size_t)j * ATT_IN * DM, DM, ATT_IN, q, j, lds);
                else gemm_phase<EPI_REC_IN>(HB, (const bf16_t*)(ws + OFF_REC_IN_T) + (size_t)j * REC_IN * DM, DM, REC_IN, q, j, lds);
                break;
            case 1:
                if ((L & 1) == 0) attn_phase(q, j, lds, ph); else { hgrn_pass<false>(q, j, lds); XBAR(); hgrn_pass<true>(q, j, lds); }
                break;
            case 2: case 5: {
                const bf16_t* Ap = (st == 2) ? HB : (const bf16_t*)(ws + OFF_P);
                const bf16_t* Bp = (st == 2) ? (((L & 1) == 0) ? (const bf16_t*)(ws + OFF_ATT_OUT_T) + (size_t)j * DM * DM : (const bf16_t*)(ws + OFF_REC_OUT_T) + (size_t)j * DM * DM)
                                             : (const bf16_t*)(ws + OFF_FFN_OUT_T) + (size_t)L * DM * FFN_H;
                gemm_phase<EPI_F32>(Ap, Bp, (st == 2) ? DM : FFN_H, DM, q, j, lds);
                break; }
            case 3:
                row_phase((const bf16_t*)(ws + OFF_T), L == 0 ? q.x : q.out, q.out, gains + DM, gains + 2 * DM, (bf16_t*)(ws + OFF_HB), q.wave);
                break;
            case 4:
                gemm_phase<EPI_FFN_IN>(HB, (const bf16_t*)(ws + OFF_FFN_IN_T) + (size_t)L * FFN_IN * DM, DM, FFN_IN, q, j, lds);
                if (L < 3) { const int rem_ = ((M_TOK / 256) * (FFN_IN / 256)) % ogrid();
                    if (obid() >= rem_) convert_layer_weights(q, L + 1, obid() - rem_, ogrid() - rem_, lds, 2); }
                break;
            default:
                row_phase((const bf16_t*)(ws + OFF_T), q.out, q.out, gains + 3 * DM, L < 3 ? gains + 4 * DM : nullptr, L < 3 ? (bf16_t*)(ws + OFF_HB) : nullptr, q.wave);
                break;
            }
        }
        if (ph + 1 < p.ph_hi) { if (p.ph_hi < 0) grid.sync(); else XBAR(); }
    }
}

#ifndef ONE_LAUNCH
#define ONE_LAUNCH 1
#endif

extern "C" void kernel_launch(void* const* d_in, const int* in_sizes, int n_in, void* d_out, int out_size, void* d_ws, size_t ws_size, hipStream_t stream) {
    static int grid_blocks = 0;
    if (!grid_blocks) {
        int dev = 0, cus = 0, per_cu = 0;
        hipGetDevice(&dev);
        hipDeviceGetAttribute(&cus, hipDeviceAttributeMultiprocessorCount, dev);
        hipOccupancyMaxActiveBlocksPerMultiprocessor(&per_cu, fwd_kernel, NTHREADS, 0);
        if (per_cu > 1) per_cu = 1;
        grid_blocks = cus * per_cu;
        if (ws_size < WS_NEED) { fprintf(stderr, "workspace too small: %zu < %zu\n", ws_size, (size_t)WS_NEED); grid_blocks = 0; return; }
    }
    Params p{};
    p.x = (const float*)d_in[0]; p.norm_gains = (const float*)d_in[1]; p.att_w_in = (const float*)d_in[2]; p.att_lambda = (const float*)d_in[3];
    p.att_subln = (const float*)d_in[4]; p.att_w_out = (const float*)d_in[5]; p.rec_w_in = (const float*)d_in[6]; p.rec_lb = (const float*)d_in[7];
    p.rec_gnorm = (const float*)d_in[8]; p.rec_w_out = (const float*)d_in[9]; p.ffn_w_in = (const float*)d_in[10]; p.ffn_w_out = (const float*)d_in[11];
    p.out = (float*)d_out; p.ws = (unsigned char*)d_ws;
    hipMemsetAsync((char*)d_ws + OFF_BAR, 0, 16384, stream);
#if ONE_LAUNCH
    p.ph_lo = 0; p.ph_hi = NPH;
    void* args[] = {&p};
    hipError_t e = hipLaunchCooperativeKernel((void*)fwd_kernel, dim3(grid_blocks), dim3(NTHREADS), args, 0, stream);
    if (e != hipSuccess) fprintf(stderr, "cooperative launch failed: %s (grid %d)\n", hipGetErrorString(e), grid_blocks);
#else
    for (int ph = 0; ph < NPH; ++ph) {
        p.ph_lo = ph; p.ph_hi = ph + 1;
        void* args[] = {&p};
        hipLaunchCooperativeKernel((void*)fwd_kernel, dim3(grid_blocks), dim3(NTHREADS), args, 0, stream);
    }
#endif
}
```
